# Optimizing an MI355X kernel written in HIP

```python
import jax, jax.numpy as jnp
from jax import lax
import numpy as np

D_MODEL = 2048
BATCH = 4
SEQ = 2048
DEPTH = 4
DEC_BATCH = 8
DEC_SEQ = 8
PAST_LEN = 16384
PAGE_SIZE = 128

N_MIXERS = 2
N_A_LAYERS = (DEPTH + 1) // 2
N_B_LAYERS = DEPTH // 2
WINDOWS = (128, 512, 2048)
DILATIONS = (1, 4, 16)
N_GROUPS = 3
H_G = 4
HD_A = 128
BLOCK = 128
CONV_W = 3
N_MEM = 256
H_M = 4
HD_M = D_MODEL // H_M
D_FF = 5632
EPS = 1e-6
NEG = -1e30

kernel_name = "hybrid_dilated_shortconv_decoder_step"


def _rmsnorm(x, g):
    x32 = x.astype(jnp.float32)
    y = x32 * lax.rsqrt(jnp.mean(x32 * x32, axis=-1, keepdims=True) + EPS)
    return (y * g.astype(jnp.float32)).astype(x.dtype)


def _causal_dwconv(u, prev, w):
    ext = jnp.concatenate([prev.astype(u.dtype), u], axis=1)
    T = u.shape[1]
    out = w[0] * ext[:, 0:T]
    for k in range(1, CONV_W):
        out = out + w[k] * ext[:, k:k + T]
    return out, ext[:, ext.shape[1] - (CONV_W - 1):]


def _dilated_band(q, k, v, dil, n_back):
    N, S, H, E = q.shape
    L = S // dil
    nb = -(-L // BLOCK)
    Lp = nb * BLOCK

    def prep(a):
        a = a.astype(jnp.float32).reshape(N, L, dil, H, E).transpose(0, 2, 1, 3, 4)
        a = jnp.pad(a, ((0, 0), (0, 0), (0, Lp - L), (0, 0), (0, 0)))
        return a.reshape(N, dil, nb, BLOCK, H, E)

    def band(a):
        prev = jnp.pad(a, ((0, 0), (0, 0), (1, 0), (0, 0), (0, 0), (0, 0)))[:, :, :nb]
        return jnp.concatenate([prev, a], axis=3)

    qb = prep(q)
    kk, vv = band(prep(k)), band(prep(v))
    s = jnp.einsum('nrbqhe,nrbkhe->nrbhqk', qb, kk) * (HD_A ** -0.5)
    qi = jnp.arange(BLOCK)[:, None] + BLOCK
    ki = jnp.arange(2 * BLOCK)[None, :]
    dist = qi - ki
    kpos = jnp.arange(nb)[:, None, None] * BLOCK - BLOCK + ki[None]
    valid = ((dist >= 0) & (dist <= n_back))[None] & (kpos >= 0)
    s = jnp.where(valid[None, None, :, None], s, NEG)
    lse = jax.nn.logsumexp(s, axis=-1)
    p = jnp.exp(s - lse[..., None])
    o = jnp.einsum('nrbhqk,nrbkhe->nrbqhe', p, vv)
    o = o.reshape(N, dil, Lp, H, E)[:, :, :L].transpose(0, 2, 1, 3, 4).reshape(N, S, H, E)
    lse = lse.transpose(0, 1, 2, 4, 3).reshape(N, dil, Lp, H)[:, :, :L]
    lse = lse.transpose(0, 2, 1, 3).reshape(N, S, H)
    return o, lse


def _dilated_gather(q, k_ext, v_ext, n_buf, dil, n_back):
    T = q.shape[1]
    idx = n_buf + jnp.arange(T)[:, None] - dil * jnp.arange(n_back + 1)[None, :]
    valid = idx >= 0
    idx = jnp.maximum(idx, 0)
    kg = k_ext.astype(jnp.float32)[:, idx]
    vg = v_ext.astype(jnp.float32)[:, idx]
    s = jnp.einsum('nthe,ntmhe->nthm', q.astype(jnp.float32), kg) * (HD_A ** -0.5)
    s = jnp.where(valid[None, :, None, :], s, NEG)
    lse = jax.nn.logsumexp(s, axis=-1)
    p = jnp.exp(s - lse[..., None])
    return jnp.einsum('nthm,ntmhe->nthe', p, vg), lse


def _merge_groups(outs, lses, w_out, dtype):
    wts = jax.nn.softmax(jnp.stack(lses), axis=0)
    o = jnp.einsum('gnth,gnthe->nthe', wts, jnp.stack(outs))
    N, T = o.shape[0], o.shape[1]
    return o.reshape(N, T, H_G * HD_A).astype(dtype) @ w_out


def _mixer_a_prompt(h, w_in, w_out):
    N, S, _ = h.shape
    qkv = (h @ w_in).reshape(N, S, N_GROUPS, 3, H_G, HD_A)
    outs, lses, bufs = [], [], []
    for g in range(N_GROUPS):
        o, lse = _dilated_band(qkv[:, :, g, 0], qkv[:, :, g, 1], qkv[:, :, g, 2],
                               DILATIONS[g], WINDOWS[g] // DILATIONS[g])
        outs.append(o)
        lses.append(lse)
        bufs.append(qkv[:, S - min(WINDOWS[g], S):, g, 1:])
    return _merge_groups(outs, lses, w_out, h.dtype), bufs


def _mixer_a_sample(h, bufs, w_in, w_out):
    N, T, _ = h.shape
    qkv = (h @ w_in).reshape(N, T, N_GROUPS, 3, H_G, HD_A)
    outs, lses, new_bufs = [], [], []
    for g in range(N_GROUPS):
        buf = bufs[g].astype(h.dtype)
        n_buf = buf.shape[1]
        ext = jnp.concatenate([buf, qkv[:, :, g, 1:]], axis=1)
        o, lse = _dilated_gather(qkv[:, :, g, 0], ext[:, :, 0], ext[:, :, 1], n_buf,
                                 DILATIONS[g], WINDOWS[g] // DILATIONS[g])
        outs.append(o)
        lses.append(lse)
        keep = min(WINDOWS[g], PAST_LEN + T)
        new_bufs.append(ext[:, ext.shape[1] - keep:])
    return _merge_groups(outs, lses, w_out, h.dtype), new_bufs


def _mixer_b(h, prev, w_in, w_conv, w_out):
    N, T, _ = h.shape
    u = (h @ w_in).reshape(N, T, 3, D_MODEL)
    gate_b, gate_c, val = u[:, :, 0], u[:, :, 1], u[:, :, 2]
    c, st = _causal_dwconv(gate_c * val, prev, w_conv)
    return (gate_b * c) @ w_out, st


def _mem_kv(mem, g, w_kv):
    N, M, _ = mem.shape
    return (_rmsnorm(mem, g) @ w_kv).reshape(N, M, 2, H_M, HD_M)


def _mem_attend(h, kv, w_q, w_o):
    N, T, _ = h.shape
    q = (h @ w_q).reshape(N, T, H_M, HD_M).astype(jnp.float32)
    k = kv[:, :, 0].astype(jnp.float32)
    v = kv[:, :, 1].astype(jnp.float32)
    s = jnp.einsum('nthe,nmhe->nhtm', q, k) * (HD_M ** -0.5)
    p = jax.nn.softmax(s, axis=-1)
    o = jnp.einsum('nhtm,nmhe->nthe', p, v)
    return o.reshape(N, T, H_M * HD_M).astype(h.dtype) @ w_o


def _conv_ffn(h, prev, w_up, w_conv, w_down):
    u, st = _causal_dwconv(h @ w_up, prev, w_conv)
    a, b = jnp.split(u, 2, axis=-1)
    return (jax.nn.silu(a) * b) @ w_down, st


def setup_inputs(seed: int = 0) -> dict:
    key = jax.random.key(seed)
    ks = jax.random.split(key, 32)
    f32 = jnp.float32

    def nrm(k, shape, scale=1.0):
        return jax.random.normal(k, shape, f32) * scale

    def gain(k, shape):
        return 1.0 + 0.05 * jax.random.normal(k, shape, f32)

    nbuf = [min(w, PAST_LEN) for w in WINDOWS]
    qkv_a = N_GROUPS * 3 * H_G * HD_A
    return {
        "x_prompt": nrm(ks[0], (BATCH, SEQ, D_MODEL)),
        "x_sample": nrm(ks[1], (DEC_BATCH, DEC_SEQ, D_MODEL)),
        "mem_prompt": nrm(ks[2], (BATCH, N_MEM, D_MODEL)),
        "cache_win0_kv": nrm(ks[3], (N_A_LAYERS, DEC_BATCH, nbuf[0], 2, H_G, HD_A)),
        "cache_win1_kv": nrm(ks[4], (N_A_LAYERS, DEC_BATCH, nbuf[1], 2, H_G, HD_A)),
        "cache_win2_kv": nrm(ks[5], (N_A_LAYERS, DEC_BATCH, nbuf[2], 2, H_G, HD_A)),
        "state_conv_b": nrm(ks[6], (N_B_LAYERS, DEC_BATCH, CONV_W - 1, D_MODEL)),
        "state_ffn_conv": nrm(ks[7], (DEPTH, DEC_BATCH, CONV_W - 1, 2 * D_FF)),
        "cache_mem_kv": nrm(ks[8], (DEPTH, DEC_BATCH, N_MEM, 2, H_M, HD_M)),
        "g_mix": gain(ks[9], (DEPTH, D_MODEL)),
        "g_mem_q": gain(ks[10], (DEPTH, D_MODEL)),
        "g_mem_kv": gain(ks[11], (DEPTH, D_MODEL)),
        "g_ffn": gain(ks[12], (DEPTH, D_MODEL)),
        "g_final": gain(ks[13], (D_MODEL,)),
        "w_in_a": nrm(ks[14], (N_A_LAYERS, D_MODEL, qkv_a), D_MODEL ** -0.5),
        "w_out_a": nrm(ks[15], (N_A_LAYERS, H_G * HD_A, D_MODEL), (H_G * HD_A) ** -0.5),
        "w_in_b": nrm(ks[16], (N_B_LAYERS, D_MODEL, 3 * D_MODEL), D_MODEL ** -0.5),
        "conv_b": nrm(ks[17], (N_B_LAYERS, CONV_W, D_MODEL), CONV_W ** -0.5),
        "w_out_b": nrm(ks[18], (N_B_LAYERS, D_MODEL, D_MODEL), D_MODEL ** -0.5),
        "w_q_mem": nrm(ks[19], (DEPTH, D_MODEL, H_M * HD_M), D_MODEL ** -0.5),
        "w_kv_mem": nrm(ks[20], (DEPTH, D_MODEL, 2 * H_M * HD_M), D_MODEL ** -0.5),
        "w_o_mem": nrm(ks[21], (DEPTH, H_M * HD_M, D_MODEL), (H_M * HD_M) ** -0.5),
        "w_up": nrm(ks[22], (DEPTH, D_MODEL, 2 * D_FF), D_MODEL ** -0.5),
        "conv_ffn": nrm(ks[23], (DEPTH, CONV_W, 2 * D_FF), CONV_W ** -0.5),
        "w_down": nrm(ks[24], (DEPTH, D_FF, D_MODEL), D_FF ** -0.5),
    }


def reference(x_prompt, x_sample, mem_prompt, cache_win0_kv, cache_win1_kv, cache_win2_kv,
              state_conv_b, state_ffn_conv, cache_mem_kv, g_mix, g_mem_q, g_mem_kv, g_ffn, g_final,
              w_in_a, w_out_a, w_in_b, conv_b, w_out_b, w_q_mem, w_kv_mem, w_o_mem,
              w_up, conv_ffn, w_down):
    n_p = x_prompt.shape[0]
    dt = x_prompt.dtype
    yp, ys = x_prompt, x_sample
    win_p = [[] for _ in range(N_GROUPS)]
    win_s = [[] for _ in range(N_GROUPS)]
    conv_p, conv_s, ffn_p, ffn_s, mem_p = [], [], [], [], []
    for i in range(DEPTH):
        j = i // N_MIXERS
        hp, hs = _rmsnorm(yp, g_mix[i]), _rmsnorm(ys, g_mix[i])
        if i % N_MIXERS == 0:
            op, bp = _mixer_a_prompt(hp, w_in_a[j], w_out_a[j])
            osm, bs = _mixer_a_sample(hs, (cache_win0_kv[j], cache_win1_kv[j], cache_win2_kv[j]),
                                      w_in_a[j], w_out_a[j])
            for g in range(N_GROUPS):
                win_p[g].append(bp[g])
                win_s[g].append(bs[g])
        else:
            zp = jnp.zeros((n_p, CONV_W - 1, D_MODEL), dt)
            op, sp = _mixer_b(hp, zp, w_in_b[j], conv_b[j], w_out_b[j])
            osm, ss = _mixer_b(hs, state_conv_b[j], w_in_b[j], conv_b[j], w_out_b[j])
            conv_p.append(sp)
            conv_s.append(ss)
        yp = yp + op
        ys = ys + osm
        kv_p = _mem_kv(mem_prompt, g_mem_kv[i], w_kv_mem[i])
        mem_p.append(kv_p)
        yp = yp + _mem_attend(_rmsnorm(yp, g_mem_q[i]), kv_p, w_q_mem[i], w_o_mem[i])
        ys = ys + _mem_attend(_rmsnorm(ys, g_mem_q[i]), cache_mem_kv[i], w_q_mem[i], w_o_mem[i])
        zf = jnp.zeros((n_p, CONV_W - 1, 2 * D_FF), dt)
        fp, sfp = _conv_ffn(_rmsnorm(yp, g_ffn[i]), zf, w_up[i], conv_ffn[i], w_down[i])
        fs, sfs = _conv_ffn(_rmsnorm(ys, g_ffn[i]), state_ffn_conv[i], w_up[i], conv_ffn[i], w_down[i])
        ffn_p.append(sfp)
        ffn_s.append(sfs)
        yp = yp + fp
        ys = ys + fs
    y_prompt = _rmsnorm(yp, g_final)
    y_sample = _rmsnorm(ys, g_final)
    p_win0, p_win1, p_win2 = jnp.stack(win_p[0]), jnp.stack(win_p[1]), jnp.stack(win_p[2])
    s_win0, s_win1, s_win2 = jnp.stack(win_s[0]), jnp.stack(win_s[1]), jnp.stack(win_s[2])
    p_conv_b, s_conv_b = jnp.stack(conv_p), jnp.stack(conv_s)
    p_ffn_conv, s_ffn_conv = jnp.stack(ffn_p), jnp.stack(ffn_s)
    p_mem_kv = jnp.stack(mem_p)
    return (y_prompt, y_sample, p_win0, p_win1, p_win2, p_conv_b, p_ffn_conv, p_mem_kv,
            s_win0, s_win1, s_win2, s_conv_b, s_ffn_conv)
```

```cpp
#include <hip/hip_runtime.h>
#include <cstdio>
#include <cstdint>
namespace pg8 {
#define PG8_LAS __attribute__((address_space(3)))
typedef unsigned short bf16_t;
typedef short bf16x8 __attribute__((ext_vector_type(8)));
typedef float f32x4 __attribute__((ext_vector_type(4)));
typedef unsigned u32x4 __attribute__((ext_vector_type(4)));
constexpr int BM = 256, BK = 64, HALF = 128, HTB = HALF * BK * 2  , STAGE_BYTES = 8 * HTB, NXCD = 8, WGM = 8;

__host__ __device__ __forceinline__ int lds_byte(int r, int c) { const int st = (r >> 4) * 2 + (c >> 5), rr = r & 15, cc = c & 31, ob = rr * 64 + cc * 2; return st * 1024 + (ob ^ (((ob >> 9) & 1) << 5)); }
__host__ __device__ __forceinline__ void stage_rc(int b, int& R, int& C) { const int st = b / 1024, sb = b % 1024, swz = sb ^ (((sb >> 9) & 1) << 5); R = (st >> 1) * 16 + swz / 64; C = (st & 1) * 32 + (swz % 64) / 2; }
__host__ __device__ __forceinline__ int perm32(int rho) { const int n = rho >> 4, i = rho & 15; return 8 * (i >> 2) + 4 * n + (i & 3); }

struct Unit { int pm, pn; };
struct Gemm { const bf16_t* A; const bf16_t* Bt; int M, N, K; };

struct StaticOrder {
    int nM, nN, nwg, G, c;
    __host__ __device__ void init(int M, int N, int G_, int c_) { nM = M / BM; nN = N / BM; nwg = nM * nN; G = G_; c = c_; }
    __host__ __device__ bool next(int i, Unit& u) const {
        const long L = (long)i * G + c; if (L >= nwg) return false;
        int wgid = (int)L; { const int q = nwg / NXCD, r = nwg % NXCD, xcd = wgid % NXCD, off = wgid / NXCD; wgid = (xcd < r ? xcd * (q + 1) : r * (q + 1) + (xcd - r) * q) + off; }
        const int nig = WGM * nN, gid = wgid / nig, fm = gid * WGM, gsz = (nM - fm) < WGM ? (nM - fm) : WGM;
        u.pm = fm + ((wgid % nig) % gsz); u.pn = (wgid % nig) / gsz; return true;
    }
    __device__ __forceinline__ void a_ready(const Unit&) const {}
    __device__ __forceinline__ void done(const Unit&) const {}
};

__device__ __forceinline__ unsigned cvt_pk_bf16(float lo, float hi) { unsigned r; asm volatile("v_cvt_pk_bf16_f32 %0, %1, %2" : "=v"(r) : "v"(lo), "v"(hi)); return r; }
typedef float f32x2 __attribute__((ext_vector_type(2)));
template <class Epi, class Sched, bool ALIGN_EPI = false, bool SP2 = false>
__device__ __forceinline__ void gemm_phase(PG8_LAS unsigned char* lds, const Gemm g, const Sched& S, const Epi& E) {
    int tid_ = threadIdx.x; asm volatile("" : "+v"(tid_));
    const int tid = tid_, wid = __builtin_amdgcn_readfirstlane(tid >> 6), lane = tid & 63, wr = wid >> 2, wc = wid & 3, fr = lane & 15, fq = lane >> 4;
    const int K = g.K, nt = K / BK;
    unsigned voffA[2], voffB[2];
#pragma unroll
    for (int i = 0; i < 2; ++i) { int R, C; stage_rc(tid * 16 + i * 8192, R, C); const int Rb = Epi::PERM ? ((R & ~31) + perm32(R & 31)) : R;
        voffA[i] = (unsigned)(R * K + C) * 2u; voffB[i] = (unsigned)(Rb * K + C) * 2u; }
    const size_t kstep = (size_t)(BK * 2);
    const size_t hstep = (size_t)HALF * K * 2;
    const size_t tstep = 2 * hstep;
    const unsigned ldsw = (unsigned)wid * 1024u;
    const int aoff = lds_byte(wr * 64 + fr, fq * 8), boff = lds_byte(wc * 32 + fr, fq * 8);
#define PG8_SA(b, h) (((b) * 2 + (h)) * HTB)
#define PG8_SB(b, h) ((4 + (b) * 2 + (h)) * HTB)
#define PG8_STAGE(bufoff, gbase, voff) do { _Pragma("unroll") for (int _i = 0; _i < 2; ++_i) \
        __builtin_amdgcn_global_load_lds((const unsigned*)((const char*)(gbase) + (voff)[_i]), (PG8_LAS unsigned*)(lds + (bufoff) + ldsw + _i * 8192), 16, 0, 0); } while (0)
#define PG8_LDA(dst, b, h) do { _Pragma("unroll") for (int m = 0; m < 4; ++m) _Pragma("unroll") for (int k = 0; k < 2; ++k) dst[m][k] = *(const PG8_LAS bf16x8*)(lds + PG8_SA(b, h) + aoff + m * 2048 + k * 1024); } while (0)
#define PG8_LDB(dst, b, h) do { _Pragma("unroll") for (int n = 0; n < 2; ++n) _Pragma("unroll") for (int k = 0; k < 2; ++k) dst[n][k] = *(const PG8_LAS bf16x8*)(lds + PG8_SB(b, h) + boff + n * 2048 + k * 1024); } while (0)
#define PG8_MMA(ai, bj, At, Bt) do { __builtin_amdgcn_s_setprio(1); _Pragma("unroll") for (int m = 0; m < 4; ++m) _Pragma("unroll") for (int n = 0; n < 2; ++n) _Pragma("unroll") for (int k = 0; k < 2; ++k) \
        acc[ai][bj][m][n] = __builtin_amdgcn_mfma_f32_16x16x32_bf16(Bt[n][k], At[m][k], acc[ai][bj][m][n], 0, 0, 0); __builtin_amdgcn_s_setprio(0); } while (0)
#define PG8_WAIT_V(n) asm volatile("s_waitcnt vmcnt(" #n ")" ::: "memory")
#define PG8_WAIT_L(n) asm volatile("s_waitcnt lgkmcnt(" #n ")" ::: "memory")
#define PG8_BAR __builtin_amdgcn_s_barrier()
#define PG8_SCHED __builtin_amdgcn_sched_barrier(0)
    Unit cur, nxt; int ui = 0;
    if (!S.next(0, cur)) return;
    f32x4 acc[2][2][4][2];
#pragma unroll
    for (int a = 0; a < 2; ++a)
#pragma unroll
        for (int b = 0; b < 2; ++b)
#pragma unroll
            for (int m = 0; m < 4; ++m)
#pragma unroll
                for (int n = 0; n < 2; ++n) acc[a][b][m][n] = (f32x4){0.f, 0.f, 0.f, 0.f};
    bf16x8 At[4][2], B0[2][2], B1[2][2];
    const char* cA = (const char*)g.A + (size_t)cur.pm * tstep; const char* cB = (const char*)g.Bt + (size_t)cur.pn * tstep;
    S.a_ready(cur);
    if constexpr (SP2) {
        PG8_STAGE(PG8_SB(0, 0), cB, voffB); PG8_STAGE(PG8_SB(0, 1), cB + hstep, voffB); PG8_STAGE(PG8_SA(0, 0), cA, voffA); PG8_STAGE(PG8_SA(0, 1), cA + hstep, voffA);
        if (wr == 1) PG8_BAR;
        PG8_WAIT_V(2); PG8_BAR;
        PG8_STAGE(PG8_SB(1, 0), cB + kstep, voffB); PG8_STAGE(PG8_SA(1, 0), cA + kstep, voffA); PG8_STAGE(PG8_SB(1, 1), cB + hstep + kstep, voffB);
        PG8_WAIT_V(6); PG8_BAR;
    } else {
        PG8_STAGE(PG8_SB(0, 0), cB, voffB); PG8_STAGE(PG8_SA(0, 0), cA, voffA); PG8_STAGE(PG8_SB(0, 1), cB + hstep, voffB); PG8_STAGE(PG8_SA(0, 1), cA + hstep, voffA);
        if (wr == 1) PG8_BAR;
        PG8_WAIT_V(4); PG8_BAR;
        PG8_STAGE(PG8_SB(1, 0), cB + kstep, voffB); PG8_STAGE(PG8_SA(1, 0), cA + kstep, voffA); PG8_STAGE(PG8_SB(1, 1), cB + hstep + kstep, voffB);
        PG8_WAIT_V(6); PG8_BAR;
    }
    for (;;) {
        const bool has_next = S.next(ui + 1, nxt);
        const char* nA = has_next ? (const char*)g.A + (size_t)nxt.pm * tstep : cA; const char* nB = has_next ? (const char*)g.Bt + (size_t)nxt.pn * tstep : cB;
        for (int t = 0; t < nt; t += 2) {
            const bool last = (t == nt - 2);
            const char* a1 = cA + (size_t)(t + 1) * kstep;
            const char* a2 = last ? nA : cA + (size_t)(t + 2) * kstep; const char* b2 = last ? nB : cB + (size_t)(t + 2) * kstep;
            const char* a3 = a2 + kstep; const char* b3 = b2 + kstep;
            if (last && has_next) S.a_ready(nxt);
            if constexpr (SP2) {
            PG8_LDB(B0, 0, 0); PG8_LDB(B1, 0, 1); PG8_SCHED; PG8_LDA(At, 0, 0); PG8_STAGE(PG8_SA(1, 1), a1 + hstep, voffA);
            PG8_WAIT_V(8); PG8_WAIT_L(0); PG8_BAR; PG8_MMA(0, 0, At, B0); PG8_MMA(0, 1, At, B1); PG8_BAR; PG8_SCHED;
            PG8_LDA(At, 0, 1); PG8_STAGE(PG8_SB(0, 0), b2, voffB); PG8_STAGE(PG8_SB(0, 1), b2 + hstep, voffB); PG8_STAGE(PG8_SA(0, 0), a2, voffA);
            PG8_WAIT_V(8); PG8_WAIT_L(0); PG8_BAR; PG8_MMA(1, 0, At, B0); PG8_MMA(1, 1, At, B1); PG8_BAR; PG8_SCHED;
            PG8_LDB(B0, 1, 0); PG8_LDB(B1, 1, 1); PG8_SCHED; PG8_LDA(At, 1, 0); PG8_STAGE(PG8_SA(0, 1), a2 + hstep, voffA);
            PG8_WAIT_V(8); PG8_WAIT_L(0); PG8_BAR; PG8_MMA(0, 0, At, B0); PG8_MMA(0, 1, At, B1); PG8_BAR; PG8_SCHED;
            PG8_LDA(At, 1, 1); PG8_STAGE(PG8_SB(1, 0), b3, voffB); PG8_STAGE(PG8_SB(1, 1), b3 + hstep, voffB); PG8_STAGE(PG8_SA(1, 0), a3, voffA);
            PG8_WAIT_V(8); PG8_WAIT_L(0); PG8_BAR; PG8_MMA(1, 0, At, B0); PG8_MMA(1, 1, At, B1); PG8_BAR; PG8_SCHED;
            } else {
            PG8_LDB(B0, 0, 0); PG8_SCHED; PG8_LDA(At, 0, 0); PG8_STAGE(PG8_SA(1, 1), a1 + hstep, voffA);
            PG8_WAIT_L(8); PG8_BAR; PG8_WAIT_L(0); PG8_MMA(0, 0, At, B0); PG8_BAR; PG8_SCHED;
            PG8_LDB(B1, 0, 1); PG8_STAGE(PG8_SB(0, 0), b2, voffB);
            PG8_BAR; PG8_WAIT_L(0); PG8_MMA(0, 1, At, B1); PG8_BAR;
            PG8_LDA(At, 0, 1); PG8_STAGE(PG8_SA(0, 0), a2, voffA);
            PG8_BAR; PG8_WAIT_L(0); PG8_MMA(1, 0, At, B0); PG8_BAR; PG8_SCHED;
            PG8_STAGE(PG8_SB(0, 1), b2 + hstep, voffB);
            PG8_WAIT_V(6); PG8_BAR; PG8_MMA(1, 1, At, B1); PG8_BAR;
            PG8_LDB(B0, 1, 0); PG8_SCHED; PG8_LDA(At, 1, 0); PG8_STAGE(PG8_SA(0, 1), a2 + hstep, voffA);
            PG8_WAIT_L(8); PG8_BAR; PG8_WAIT_L(0); PG8_MMA(0, 0, At, B0); PG8_BAR; PG8_SCHED;
            PG8_LDB(B1, 1, 1); PG8_STAGE(PG8_SB(1, 0), b3, voffB);
            PG8_BAR; PG8_WAIT_L(0); PG8_MMA(0, 1, At, B1); PG8_BAR;
            PG8_LDA(At, 1, 1); PG8_STAGE(PG8_SA(1, 0), a3, voffA);
            PG8_BAR; PG8_WAIT_L(0); PG8_MMA(1, 0, At, B0); PG8_BAR; PG8_SCHED;
            PG8_STAGE(PG8_SB(1, 1), b3 + hstep, voffB);
            PG8_WAIT_V(6); PG8_BAR; PG8_MMA(1, 1, At, B1); PG8_BAR;
            }
        }
        if constexpr (ALIGN_EPI) { if (wr == 0) PG8_BAR; }
        if constexpr (!Epi::AFTER_DRAIN) { E(acc, cur, wr, wc, fr, fq); S.done(cur); }
        if (!has_next) break;
#pragma unroll
        for (int a = 0; a < 2; ++a)
#pragma unroll
            for (int b = 0; b < 2; ++b)
#pragma unroll
                for (int m = 0; m < 4; ++m)
#pragma unroll
                    for (int n = 0; n < 2; ++n) acc[a][b][m][n] = (f32x4){0.f, 0.f, 0.f, 0.f};
        cur = nxt; cA = nA; cB = nB; ++ui;
        if constexpr (ALIGN_EPI) { if (wr == 1) PG8_BAR; }
    }
    PG8_WAIT_V(0);
    if constexpr (!ALIGN_EPI) { if (wr == 0) PG8_BAR; }
    PG8_BAR;
    if constexpr (Epi::AFTER_DRAIN) { E.fused(acc, cur, wr, wc, fr, fq, lds, wid, lane); S.done(cur); }
#undef PG8_SA
#undef PG8_SB
#undef PG8_STAGE
#undef PG8_LDA
#undef PG8_LDB
#undef PG8_MMA
#undef PG8_WAIT_V
#undef PG8_WAIT_L
#undef PG8_BAR
#undef PG8_SCHED
}
}
namespace cfg {
constexpr int D = 2048, BATCH = 4, SEQ = 2048, DEPTH = 4, DB = 8, DS = 8, NMEM = 256, DFF = 5632, UP = 2 * DFF;
constexpr int MP = BATCH * SEQ, MS = DB * DS, MT = MP + MS, MM = BATCH * NMEM;
constexpr int NQKV = 4608, NINB = 6144;
constexpr float EPS = 1e-6f;
constexpr float LOG2E = 1.4426950408889634f, LN2 = 0.6931471805599453f;
constexpr size_t O_YP = 0;
constexpr size_t O_YS = O_YP + (size_t)BATCH * SEQ * D;
constexpr size_t O_PW0 = O_YS + (size_t)DB * DS * D;
constexpr size_t O_PW1 = O_PW0 + (size_t)2 * BATCH * 128 * 1024;
constexpr size_t O_PW2 = O_PW1 + (size_t)2 * BATCH * 512 * 1024;
constexpr size_t O_PCB = O_PW2 + (size_t)2 * BATCH * 2048 * 1024;
constexpr size_t O_PFC = O_PCB + (size_t)2 * BATCH * 2 * D;
constexpr size_t O_PMK = O_PFC + (size_t)DEPTH * BATCH * 2 * UP;
constexpr size_t O_SW0 = O_PMK + (size_t)DEPTH * BATCH * NMEM * 4096;
constexpr size_t O_SW1 = O_SW0 + (size_t)2 * DB * 128 * 1024;
constexpr size_t O_SW2 = O_SW1 + (size_t)2 * DB * 512 * 1024;
constexpr size_t O_SCB = O_SW2 + (size_t)2 * DB * 2048 * 1024;
constexpr size_t O_SFC = O_SCB + (size_t)2 * DB * 2 * D;
constexpr size_t O_END = O_SFC + (size_t)DEPTH * DB * 2 * UP;
static_assert(O_END == 100925440ull, "output size");
constexpr size_t MiB = 1u << 20;
constexpr size_t WS_CTL = 0, CTL_ZERO_BYTES = 1 * MiB;
constexpr size_t WS_WQKV = 1 * MiB;
constexpr size_t WS_WOA = WS_WQKV + 36 * MiB;
constexpr size_t WS_WINB = WS_WOA + 4 * MiB;
constexpr size_t WS_WOB = WS_WINB + 48 * MiB;
constexpr size_t WS_WQ = WS_WOB + 16 * MiB;
constexpr size_t WS_WKV = WS_WQ + 32 * MiB;
constexpr size_t WS_WO = WS_WKV + 64 * MiB;
constexpr size_t WS_WUP = WS_WO + 32 * MiB;
constexpr size_t WS_WDN = WS_WUP + 176 * MiB;
constexpr size_t WS_Y = WS_WDN + 88 * MiB;
constexpr size_t WS_YB = WS_Y + 65 * MiB;
constexpr size_t WS_SSQ = WS_YB + 33 * MiB;
constexpr size_t WS_SSQS = WS_SSQ + 1 * MiB;
constexpr size_t WS_MEMB = WS_SSQS + 1 * MiB;
constexpr size_t WS_SSQM = WS_MEMB + 4 * MiB;
constexpr size_t WS_KVB = WS_SSQM + 1 * MiB;
constexpr size_t WS_CKV = WS_KVB + 32 * MiB;
constexpr size_t WS_BIG = WS_CKV + 64 * MiB;
constexpr size_t WS_ACT = WS_BIG + 176 * MiB;
constexpr size_t WS_QM = WS_ACT, WS_OM = WS_ACT + 33 * MiB, WS_OG = WS_ACT + 33 * MiB, WS_LSE = WS_ACT + 58 * MiB, WS_MRG = WS_ACT + 66 * MiB;
constexpr size_t WS_SMALL = WS_ACT + 99 * MiB;
constexpr size_t WS_QKVS = WS_SMALL, WS_U3S = WS_SMALL + 2 * MiB, WS_US = WS_SMALL + 4 * MiB;
constexpr size_t WS_END = WS_SMALL + 8 * MiB;
static_assert((size_t)MT * 5632 * 2 <= 99 * MiB && (size_t)3 * MT * 512 * 2 <= 25 * MiB && (size_t)MT * 2048 * 2 <= 33 * MiB, "ws map");
}

namespace ep {
using pg8::f32x4; using pg8::u32x4; using pg8::bf16_t; using pg8::Unit; using pg8::cvt_pk_bf16; using pg8::HALF; using pg8::BM;
__device__ __forceinline__ float row_rstd(const float* ssq, int row, int fq) {
    const f32x4* p = (const f32x4*)(ssq + (size_t)row * 32 + fq * 8);
    const f32x4 a = p[0], b = p[1];
    float s = ((a[0] + a[1]) + (a[2] + a[3])) + ((b[0] + b[1]) + (b[2] + b[3]));
    s += __shfl_xor(s, 16); s += __shfl_xor(s, 32);
    return 1.0f / sqrtf(s * (1.0f / 2048.0f) + cfg::EPS);
}
__device__ __forceinline__ u32x4 pack8(const f32x4 v0, const f32x4 v1) { u32x4 w; w.x = cvt_pk_bf16(v0[0], v0[1]); w.y = cvt_pk_bf16(v0[2], v0[3]); w.z = cvt_pk_bf16(v1[0], v1[1]); w.w = cvt_pk_bf16(v1[2], v1[3]); return w; }

struct EpiScale {
    static constexpr bool PERM = true, AFTER_DRAIN = false;
    bf16_t* O; int ldc; const float* ssq; float scale;
    __device__ __forceinline__ void operator()(const f32x4 (&acc)[2][2][4][2], const Unit& u, int wr, int wc, int fr, int fq) const {
        const int col0 = u.pn * BM + wc * 32 + 8 * fq;
#pragma unroll
        for (int ai = 0; ai < 2; ++ai)
#pragma unroll
            for (int m = 0; m < 4; ++m) { const int row = u.pm * BM + ai * HALF + wr * 64 + m * 16 + fr; const float rs = row_rstd(ssq, row, fq) * scale;
                bf16_t* rowp = O + (size_t)row * ldc + col0;
#pragma unroll
                for (int bj = 0; bj < 2; ++bj) *(u32x4*)(rowp + bj * HALF) = pack8(acc[ai][bj][m][0] * rs, acc[ai][bj][m][1] * rs); }
    }
};
struct EpiQKV {
    static constexpr bool PERM = true, AFTER_DRAIN = false;
    bf16_t* O; const float* ssq; float* out; int j; float qscale;
    __device__ __forceinline__ void operator()(const f32x4 (&acc)[2][2][4][2], const Unit& u, int wr, int wc, int fr, int fq) const {
        const int colt = u.pn * BM; const int g = colt / 1536, rem = colt - g * 1536, w = rem / 512, c512 = rem - w * 512;
        const float sc = (w == 0) ? qscale : 1.f;
        const int nb = u.pm >> 3, t0 = (u.pm & 7) * BM;
        const int keep = (g == 0) ? 128 : (g == 1 ? 512 : 2048);
        float* pw = out + (g == 0 ? cfg::O_PW0 : (g == 1 ? cfg::O_PW1 : cfg::O_PW2));
        const int col0 = colt + wc * 32 + 8 * fq;
#pragma unroll
        for (int ai = 0; ai < 2; ++ai)
#pragma unroll
            for (int m = 0; m < 4; ++m) { const int rit = ai * HALF + wr * 64 + m * 16 + fr, row = u.pm * BM + rit, t = t0 + rit; const float r0 = row_rstd(ssq, row, fq), rs = r0 * sc;
                bf16_t* rowp = O + (size_t)row * cfg::NQKV + col0;
#pragma unroll
                for (int bj = 0; bj < 2; ++bj) *(u32x4*)(rowp + bj * HALF) = pack8(acc[ai][bj][m][0] * rs, acc[ai][bj][m][1] * rs);
                if (w >= 1 && t >= 2048 - keep) {
                    float* d = pw + ((((size_t)(j * 4 + nb) * keep + (t - (2048 - keep))) * 2 + (w - 1)) * 512) + c512 + wc * 32 + 8 * fq;
#pragma unroll
                    for (int bj = 0; bj < 2; ++bj) { *(f32x4*)(d + bj * HALF) = acc[ai][bj][m][0] * r0; *(f32x4*)(d + bj * HALF + 4) = acc[ai][bj][m][1] * r0; }
                } }
    }
};
struct EpiUp {
    static constexpr bool PERM = true, AFTER_DRAIN = false;
    bf16_t* O; const float* ssq; float* out; int layer;
    __device__ __forceinline__ void operator()(const f32x4 (&acc)[2][2][4][2], const Unit& u, int wr, int wc, int fr, int fq) const {
        const int col0 = u.pn * BM + wc * 32 + 8 * fq; const int nb = u.pm >> 3, t0 = (u.pm & 7) * BM;
#pragma unroll
        for (int ai = 0; ai < 2; ++ai)
#pragma unroll
            for (int m = 0; m < 4; ++m) { const int rit = ai * HALF + wr * 64 + m * 16 + fr, row = u.pm * BM + rit, t = t0 + rit; const float rs = row_rstd(ssq, row, fq);
                bf16_t* rowp = O + (size_t)row * cfg::UP + col0;
#pragma unroll
                for (int bj = 0; bj < 2; ++bj) *(u32x4*)(rowp + bj * HALF) = pack8(acc[ai][bj][m][0] * rs, acc[ai][bj][m][1] * rs);
                if (t >= 2046) { float* d = out + cfg::O_PFC + ((size_t)(layer * 4 + nb) * 2 + (t - 2046)) * cfg::UP + col0;
#pragma unroll
                    for (int bj = 0; bj < 2; ++bj) { *(f32x4*)(d + bj * HALF) = acc[ai][bj][m][0] * rs; *(f32x4*)(d + bj * HALF + 4) = acc[ai][bj][m][1] * rs; } } }
    }
};
struct EpiKV {
    static constexpr bool PERM = true, AFTER_DRAIN = false;
    bf16_t* O; const float* ssq; float* out;
    __device__ __forceinline__ void operator()(const f32x4 (&acc)[2][2][4][2], const Unit& u, int wr, int wc, int fr, int fq) const {
        const int layer = u.pn >> 4, col0 = (u.pn & 15) * BM + wc * 32 + 8 * fq;
#pragma unroll
        for (int ai = 0; ai < 2; ++ai)
#pragma unroll
            for (int m = 0; m < 4; ++m) { const int row = u.pm * BM + ai * HALF + wr * 64 + m * 16 + fr; const float rs = row_rstd(ssq, row, fq);
                const size_t off = ((size_t)layer * cfg::MM + row) * 4096 + col0;
#pragma unroll
                for (int bj = 0; bj < 2; ++bj) { const f32x4 v0 = acc[ai][bj][m][0] * rs, v1 = acc[ai][bj][m][1] * rs;
                    *(u32x4*)(O + off + bj * HALF) = pack8(v0, v1); *(f32x4*)(out + cfg::O_PMK + off + bj * HALF) = v0; *(f32x4*)(out + cfg::O_PMK + off + bj * HALF + 4) = v1; } }
    }
};
struct EpiResid {
    static constexpr bool PERM = true, AFTER_DRAIN = false;
    float* Y; bf16_t* YB; float* ssq;
    __device__ __forceinline__ void operator()(const f32x4 (&acc)[2][2][4][2], const Unit& u, int wr, int wc, int fr, int fq) const {
        const int col0 = u.pn * BM + wc * 32 + 8 * fq;
#pragma unroll
        for (int ai = 0; ai < 2; ++ai)
#pragma unroll
            for (int m = 0; m < 4; ++m) { const int row = u.pm * BM + ai * HALF + wr * 64 + m * 16 + fr; const size_t off = (size_t)row * 2048 + col0; float part = 0.f;
#pragma unroll
                for (int bj = 0; bj < 2; ++bj) { f32x4 y0 = *(const f32x4*)(Y + off + bj * HALF), y1 = *(const f32x4*)(Y + off + bj * HALF + 4);
                    y0 += acc[ai][bj][m][0]; y1 += acc[ai][bj][m][1];
                    *(f32x4*)(Y + off + bj * HALF) = y0; *(f32x4*)(Y + off + bj * HALF + 4) = y1; *(u32x4*)(YB + off + bj * HALF) = pack8(y0, y1);
                    part += ((y0[0] * y0[0] + y0[1] * y0[1]) + (y0[2] * y0[2] + y0[3] * y0[3])) + ((y1[0] * y1[0] + y1[1] * y1[1]) + (y1[2] * y1[2] + y1[3] * y1[3])); }
                part += __shfl_xor(part, 16); part += __shfl_xor(part, 32);
                if (fq == 0) ssq[(size_t)row * 32 + u.pn * 4 + wc] = part;
                if (m & 1) asm volatile("" ::: "memory"); }
    }
};
}
#define GAS __attribute__((address_space(1)))
#define LAS __attribute__((address_space(3)))
typedef unsigned short bf16;
typedef unsigned v4u __attribute__((ext_vector_type(4)));
typedef float f32x4 __attribute__((ext_vector_type(4)));
typedef short bf16x8 __attribute__((ext_vector_type(8)));
typedef GAS unsigned gu32;
typedef GAS unsigned long long gu64;
#define RLX_AGENT __ATOMIC_RELAXED, __HIP_MEMORY_SCOPE_AGENT
#define LDS_WAIT() asm volatile("s_waitcnt lgkmcnt(0)" ::: "memory")
#define VM_WAIT() asm volatile("s_waitcnt vmcnt(0)" ::: "memory")
__device__ __forceinline__ unsigned long long rt() { return __builtin_amdgcn_s_memrealtime(); }
__device__ __forceinline__ unsigned f2bf(float f) { unsigned u = __builtin_bit_cast(unsigned, f); return (u + 0x7fffu + ((u >> 16) & 1u)) >> 16; }
__device__ __forceinline__ unsigned pk2(float lo, float hi) { return f2bf(lo) | (f2bf(hi) << 16); }

#define XB_TMO      128
#define XB_XCNT(j)  (256  + 64 * (j))
#define XB_XSUB(j)  (1280 + 64 * (j))
#define XB_XGEN(j)  (2304 + 64 * (j))
#define XB_TOP      3328
#define XB_TOPGEN   3392
#define XCD_BAR_WORDS 3456
#define XB_SPIN_CAP (1u << 18)

__device__ __forceinline__ unsigned xb_ld(unsigned* p)              { return __hip_atomic_load(p, __ATOMIC_RELAXED, __HIP_MEMORY_SCOPE_AGENT); }
__device__ __forceinline__ unsigned xb_add(unsigned* p, unsigned v) { return __hip_atomic_fetch_add(p, v, __ATOMIC_RELAXED, __HIP_MEMORY_SCOPE_AGENT); }
__device__ __forceinline__ unsigned xb_xcc_id() { return (unsigned)__builtin_amdgcn_s_getreg((3 << 11) | 20) & 0xFu; }
#define XB_SPIN(cond, bar) do { unsigned _sp = 0; while (cond) { __builtin_amdgcn_s_sleep(1); \
    if ((++_sp & 255u) == 0u) { if (xb_ld(&(bar)[XB_TMO])) break; if (_sp > XB_SPIN_CAP) { atomicAdd(&(bar)[XB_TMO], 1u); break; } } } } while (0)

struct XcdBarrier {
    unsigned* bar; unsigned x;
    volatile LAS unsigned* st;
};

__device__ __forceinline__ XcdBarrier xcd_barrier_post(unsigned* bar, volatile LAS unsigned* st) {
    XcdBarrier b; b.bar = bar; b.x = xb_xcc_id(); b.st = st;
    if (threadIdx.x == 0) (void)xb_add(&bar[XB_XCNT(b.x)], 1u);
    return b;
}
__device__ __forceinline__ void xcd_barrier_complete(unsigned* bar, unsigned x, unsigned& nloc, unsigned& nx) {
    const unsigned G = gridDim.x * gridDim.y * gridDim.z;
    unsigned sum, cnt, mine, sp = 0u;
    for (;;) {
        sum = 0u; cnt = 0u; mine = 0u;
#pragma unroll
        for (unsigned j = 0; j < 16; ++j) { const unsigned c = xb_ld(&bar[XB_XCNT(j)]); sum += c; cnt += (c > 0u) ? 1u : 0u; mine = (j == x) ? c : mine; }
        if (sum == G) break;
        __builtin_amdgcn_s_sleep(1);
        if ((++sp & 255u) == 0u) { if (xb_ld(&bar[XB_TMO])) break; if (sp > XB_SPIN_CAP) { atomicAdd(&bar[XB_TMO], 1u); break; } }
    }
    nloc = mine > 0u ? mine : 1u; nx = cnt > 0u ? cnt : 1u;
}

__device__ __forceinline__ void xcd_barrier(const XcdBarrier& b) {
    asm volatile("s_waitcnt vmcnt(0)" ::: "memory");
    __syncthreads();
    if (threadIdx.x == 0) {
        unsigned* bar = b.bar;
        __builtin_amdgcn_s_waitcnt(0);
        unsigned nloc = b.st[0], nx = b.st[1];
        if (nloc == 0u) { xcd_barrier_complete(bar, b.x, nloc, nx); b.st[0] = nloc; b.st[1] = nx; }
        const unsigned old = xb_add(&bar[XB_XSUB(b.x)], 1u);
        const unsigned gen = old / nloc;
        if (old + 1u == (gen + 1u) * nloc) {
            __builtin_amdgcn_fence(__ATOMIC_RELEASE, "agent");
            asm volatile("s_waitcnt vmcnt(0)" ::: "memory");
            const unsigned og = xb_add(&bar[XB_TOP], 1u);
            const unsigned tg = og / nx;
            if (og + 1u == (tg + 1u) * nx) xb_add(&bar[XB_TOPGEN], 1u);
            else XB_SPIN(xb_ld(&bar[XB_TOPGEN]) == tg, bar);
            __builtin_amdgcn_fence(__ATOMIC_ACQUIRE, "agent");
            xb_add(&bar[XB_XGEN(b.x)], 1u);
            asm volatile("s_waitcnt vmcnt(0)" ::: "memory");
        } else {
            XB_SPIN(xb_ld(&bar[XB_XGEN(b.x)]) == gen, bar);
            __builtin_amdgcn_fence(__ATOMIC_ACQUIRE, "agent");
            asm volatile("s_waitcnt vmcnt(0)" ::: "memory");
        }
    }
    __syncthreads();
}
constexpr int NWAVES = 8, NTHREADS = 512;
constexpr int RING_BYTES = 131072;
constexpr int SCR_BYTES = 155648;
constexpr int MISC_OFF = SCR_BYTES;
constexpr int LDS_BYTES = SCR_BYTES + 256;
typedef unsigned u32x4g __attribute__((ext_vector_type(4)));
typedef unsigned u32x2g __attribute__((ext_vector_type(2)));
typedef float f32x2g __attribute__((ext_vector_type(2)));
typedef short s16x4g __attribute__((ext_vector_type(4)));

__device__ __forceinline__ unsigned cvtpk(float lo, float hi) { unsigned r; asm volatile("v_cvt_pk_bf16_f32 %0, %1, %2" : "=v"(r) : "v"(lo), "v"(hi)); return r; }
__device__ __forceinline__ float bf_lo(unsigned w) { return __uint_as_float(w << 16); }
__device__ __forceinline__ float bf_hi(unsigned w) { return __uint_as_float(w & 0xffff0000u); }
__device__ __forceinline__ float wave_sum(float v) {
#pragma unroll
    for (int o = 1; o < 64; o <<= 1) v += __shfl_xor(v, o);
    return v;
}
__device__ __forceinline__ float wave_max(float v) {
#pragma unroll
    for (int o = 1; o < 64; o <<= 1) v = fmaxf(v, __shfl_xor(v, o));
    return v;
}
__device__ __forceinline__ f32x4 mfma16(bf16x8 a, bf16x8 b, f32x4 c) { return __builtin_amdgcn_mfma_f32_16x16x32_bf16(a, b, c, 0, 0, 0); }
__device__ __forceinline__ s16x4g ldtr(const LAS unsigned char* p) { return __builtin_bit_cast(s16x4g, __builtin_amdgcn_ds_read_tr16_b64_v4i16((LAS s16x4g*)p)); }

__device__ __forceinline__ void unpack8(float (&d)[8], const u32x4g v) { d[0] = bf_lo(v.x); d[1] = bf_hi(v.x); d[2] = bf_lo(v.y); d[3] = bf_hi(v.y); d[4] = bf_lo(v.z); d[5] = bf_hi(v.z); d[6] = bf_lo(v.w); d[7] = bf_hi(v.w); }
__device__ __forceinline__ void p0_transpose_item(const float* W, const float* gain, int K, int N, bf16* WT, LAS float* scr, int item, int lane) {
    const int nblk = N / 32, kb = item / nblk, nb = item % nblk, k0 = 64 * kb, n0 = 32 * nb;
#pragma unroll 8
    for (int i = 0; i < 32; ++i) { const int kk = 2 * i + (lane >> 5); float v = W[(size_t)(k0 + kk) * N + n0 + (lane & 31)]; if (gain) v *= gain[k0 + kk]; scr[kk * 33 + (lane & 31)] = v; }
    LDS_WAIT(); asm volatile("" ::: "memory");
    const int c = lane & 7;
#pragma unroll
    for (int jj = 0; jj < 4; ++jj) { const int n = (lane >> 3) + 8 * jj; const LAS float* s = scr + (8 * c) * 33 + n;
        v4u o; o.x = pk2(s[0 * 33], s[1 * 33]); o.y = pk2(s[2 * 33], s[3 * 33]); o.z = pk2(s[4 * 33], s[5 * 33]); o.w = pk2(s[6 * 33], s[7 * 33]);
        *(GAS v4u*)(WT + (size_t)(n0 + n) * K + k0 + 8 * c) = o; }
    LDS_WAIT(); asm volatile("" ::: "memory");
}
__device__ __forceinline__ void p0_row(const float* xrow, float* yrow, bf16* ybrow, float* ssqrow, int nslots, int lane) {
    const GAS f32x4* xr = (const GAS f32x4*)xrow + lane;
    f32x4 v[8]; float s = 0.f;
#pragma unroll
    for (int q = 0; q < 8; ++q) { v[q] = xr[64 * q]; s += (v[q].x * v[q].x + v[q].y * v[q].y) + (v[q].z * v[q].z + v[q].w * v[q].w); }
    s = wave_sum(s);
    if (yrow) { GAS f32x4* yr = (GAS f32x4*)yrow + lane;
#pragma unroll
        for (int q = 0; q < 8; ++q) yr[64 * q] = v[q]; }
    GAS u32x2g* o8 = (GAS u32x2g*)ybrow + lane;
#pragma unroll
    for (int q = 0; q < 8; ++q) { u32x2g w; w.x = cvtpk(v[q].x, v[q].y); w.y = cvtpk(v[q].z, v[q].w); o8[64 * q] = w; }
    for (int q = lane; q < nslots; q += 64) ssqrow[q] = (q == 0) ? s : 0.f;
}

template <class F>
__device__ __forceinline__ void sample_gemm(LAS unsigned char* lds, const bf16* A, const bf16* Bt, int N, int K, int wg, int nwg, const F& epi) {
    int tid_ = threadIdx.x; asm volatile("" : "+v"(tid_));
    const int tid = tid_, wid = __builtin_amdgcn_readfirstlane(tid >> 6), lane = tid & 63, fr = lane & 15, fq = lane >> 4;
    const int kw = K >> 3;
    LAS f32x4* red = (LAS f32x4*)lds;
    for (int ct = wg; ct < (N >> 4); ct += nwg) {
        f32x4 acc[4];
#pragma unroll
        for (int r = 0; r < 4; ++r) acc[r] = (f32x4){0.f, 0.f, 0.f, 0.f};
        const bf16* bp = Bt + (size_t)(ct * 16 + fr) * K + wid * kw + 8 * fq;
        const bf16* ap = A + (size_t)fr * K + wid * kw + 8 * fq;
        for (int k = 0; k < kw; k += 32) {
            const bf16x8 b = *(const GAS bf16x8*)(bp + k);
#pragma unroll
            for (int r = 0; r < 4; ++r) { const bf16x8 a = *(const GAS bf16x8*)(ap + (size_t)r * 16 * K + k); acc[r] = mfma16(b, a, acc[r]); }
        }
#pragma unroll
        for (int r = 0; r < 4; ++r) red[(wid * 4 + r) * 64 + lane] = acc[r];
        __syncthreads();
        if (wid < 4) { f32x4 s = red[wid * 64 + lane];
#pragma unroll
            for (int w = 1; w < 8; ++w) s += red[(w * 4 + wid) * 64 + lane];
            epi(16 * wid + fr, ct * 16 + 4 * fq, s, lane); }
        __syncthreads();
    }
}
__device__ __forceinline__ void sample_rstd_table(LAS float* tab, const float* ssqs) {
    int tid_ = threadIdx.x; asm volatile("" : "+v"(tid_));
    const int tid = tid_, row = tid >> 3, part = tid & 7;
    const GAS f32x4* p = (const GAS f32x4*)(ssqs + (size_t)row * 128 + part * 16);
    float s = 0.f;
#pragma unroll
    for (int q = 0; q < 4; ++q) { const f32x4 a = p[q]; s += (a.x + a.y) + (a.z + a.w); }
    s += __shfl_xor(s, 1); s += __shfl_xor(s, 2); s += __shfl_xor(s, 4);
    if (part == 0) tab[row] = 1.0f / sqrtf(s * (1.0f / 2048.0f) + cfg::EPS);
    __syncthreads();
}
constexpr int DA_KSTR = 272, DA_VSTR = 288, DA_VOFF = 256 * DA_KSTR;
static_assert(DA_VOFF + 256 * DA_VSTR <= SCR_BYTES, "dilated attention LDS");
__device__ __forceinline__ void dattn_unit(LAS unsigned char* lds, const bf16* QKV, bf16* OG, float* LSE, int u) {
    int tid_ = threadIdx.x; asm volatile("" : "+v"(tid_));
    const int tid = tid_, wid = __builtin_amdgcn_readfirstlane(tid >> 6), lane = tid & 63, fr = lane & 15, fq = lane >> 4;
    const int n = u / 192, g = (u / 64) % 3, h = (u >> 4) & 3, x = u & 15;
    const int lg = (g == 0) ? 0 : (g == 1 ? 2 : 4), d = 1 << lg;
    const int r = x & (d - 1), b = x >> lg;
    const int cq = g * 1536 + h * 128, ck = cq + 512, cv = cq + 1024;
    const size_t rowbase = (size_t)n * 2048;
    LAS unsigned char* Ks = lds; LAS unsigned char* Vs = lds + DA_VOFF;
#pragma unroll
    for (int x8 = 0; x8 < 8; ++x8) { const int c = tid + 512 * x8, row = c >> 4, ch = c & 15, kk = 128 * (b - 1) + row;
        u32x4g kv = (u32x4g){0u, 0u, 0u, 0u}, vv = (u32x4g){0u, 0u, 0u, 0u};
        if (kk >= 0) { const bf16* src = QKV + (rowbase + (size_t)kk * d + r) * cfg::NQKV; kv = *(const GAS u32x4g*)(src + ck + ch * 8); vv = *(const GAS u32x4g*)(src + cv + ch * 8); }
        *(LAS u32x4g*)(Ks + row * DA_KSTR + ch * 16) = kv; *(LAS u32x4g*)(Vs + row * DA_VSTR + ch * 16) = vv; }
    const int iq = 128 * b + 16 * wid + fr;
    const size_t qrow = rowbase + (size_t)iq * d + r;
    bf16x8 qa[4];
#pragma unroll
    for (int ks = 0; ks < 4; ++ks) qa[ks] = *(const GAS bf16x8*)(QKV + qrow * cfg::NQKV + cq + 32 * ks + 8 * fq);
    __syncthreads();
    f32x4 st[16];
#pragma unroll
    for (int kt = 0; kt < 16; ++kt) { st[kt] = (f32x4){0.f, 0.f, 0.f, 0.f};
#pragma unroll
        for (int ks = 0; ks < 4; ++ks) { const bf16x8 kf = *(const LAS bf16x8*)(Ks + (16 * kt + fr) * DA_KSTR + (32 * ks + 8 * fq) * 2); st[kt] = mfma16(kf, qa[ks], st[kt]); } }
    float mx = -1e30f;
#pragma unroll
    for (int kt = 0; kt < 16; ++kt)
#pragma unroll
        for (int i = 0; i < 4; ++i) { const int ik = 128 * (b - 1) + 16 * kt + 4 * fq + i, dist = iq - ik; const bool valid = (dist >= 0) && (dist <= 128) && (ik >= 0);
            const float s = valid ? st[kt][i] : -1e30f; st[kt][i] = s; mx = fmaxf(mx, s); }
    mx = fmaxf(mx, __shfl_xor(mx, 16)); mx = fmaxf(mx, __shfl_xor(mx, 32));
    float sum = 0.f;
#pragma unroll
    for (int kt = 0; kt < 16; ++kt)
#pragma unroll
        for (int i = 0; i < 4; ++i) { const float p = exp2f(st[kt][i] - mx); st[kt][i] = p; sum += p; }
    sum += __shfl_xor(sum, 16); sum += __shfl_xor(sum, 32);
    bf16x8 pb[8];
#pragma unroll
    for (int s2 = 0; s2 < 8; ++s2) { u32x4g w; w.x = cvtpk(st[2 * s2][0], st[2 * s2][1]); w.y = cvtpk(st[2 * s2][2], st[2 * s2][3]); w.z = cvtpk(st[2 * s2 + 1][0], st[2 * s2 + 1][1]); w.w = cvtpk(st[2 * s2 + 1][2], st[2 * s2 + 1][3]);
        pb[s2] = __builtin_bit_cast(bf16x8, w); }
    f32x4 ot[8];
#pragma unroll
    for (int c = 0; c < 8; ++c) ot[c] = (f32x4){0.f, 0.f, 0.f, 0.f};
    const int q4 = fr >> 2, p4 = fr & 3;
    const LAS unsigned char* vb = Vs + (4 * fq + q4) * DA_VSTR + p4 * 8;
#pragma unroll
    for (int s2 = 0; s2 < 8; ++s2)
#pragma unroll
        for (int c = 0; c < 8; ++c) { const s16x4g v0 = ldtr(vb + (32 * s2) * DA_VSTR + c * 32), v1 = ldtr(vb + (32 * s2 + 16) * DA_VSTR + c * 32);
            const bf16x8 vf = (bf16x8){v0[0], v0[1], v0[2], v0[3], v1[0], v1[1], v1[2], v1[3]}; ot[c] = mfma16(vf, pb[s2], ot[c]); }
    const float inv = 1.0f / sum;
    bf16* orow = OG + ((size_t)g * cfg::MT + qrow) * 512 + h * 128 + 4 * fq;
#pragma unroll
    for (int c = 0; c < 8; ++c) { u32x2g w; w.x = cvtpk(ot[c][0] * inv, ot[c][1] * inv); w.y = cvtpk(ot[c][2] * inv, ot[c][3] * inv); *(GAS u32x2g*)(orow + 16 * c) = w; }
    if (fq == 0) LSE[((size_t)g * cfg::MT + qrow) * 4 + h] = (mx + log2f(sum)) * cfg::LN2;
    __syncthreads();
}

__device__ __forceinline__ void dattn_sample(LAS float* qs  , const float* QKVS, const float* cache0, const float* cache1, const float* cache2, int j, bf16* OG, float* LSE, int task, int lane) {
    const int n = task / 96, t = (task / 12) & 7, g = (task % 12) >> 2, h = task & 3;
    const int d = (g == 0) ? 1 : (g == 1 ? 4 : 16), W = (g == 0) ? 128 : (g == 1 ? 512 : 2048);
    const float* cache = ((g == 0) ? cache0 : (g == 1 ? cache1 : cache2)) + (size_t)(j * 8 + n) * W * 1024 + h * 128;
    const float* newb = QKVS + (size_t)(n * 8) * cfg::NQKV + g * 1536 + h * 128;
    const float* qp = newb + (size_t)t * cfg::NQKV;
    { const f32x2g qv = *(const GAS f32x2g*)(qp + 2 * lane); qs[2 * lane] = qv.x; qs[2 * lane + 1] = qv.y; }
    LDS_WAIT(); asm volatile("" ::: "memory");
    float sc[3];
#pragma unroll
    for (int rnd = 0; rnd < 3; ++rnd) { const int m = lane + 64 * rnd; float acc = -1e30f;
        if (m <= 128) { const int idx = W + t - d * m; const float* kp = (idx < W) ? (cache + (size_t)idx * 1024) : (newb + (size_t)(idx - W) * cfg::NQKV + 512);
            float a = 0.f;
#pragma unroll 8
            for (int e4 = 0; e4 < 32; ++e4) { const f32x4 kv = *(const GAS f32x4*)(kp + 4 * e4); const f32x4 qv = *(const LAS f32x4*)(qs + 4 * e4); a += (kv.x * qv.x + kv.y * qv.y) + (kv.z * qv.z + kv.w * qv.w); }
            acc = a * 0.08838834764831845f; }
        sc[rnd] = acc; }
    const float mx = wave_max(fmaxf(fmaxf(sc[0], sc[1]), sc[2]));
    float p0 = __expf(sc[0] - mx), p1 = __expf(sc[1] - mx), p2 = (lane == 0) ? __expf(sc[2] - mx) : 0.f;
    const float sum = wave_sum(p0 + p1 + p2);
    float o0 = 0.f, o1 = 0.f;
    for (int m = 0; m <= 128; ++m) { const int idx = W + t - d * m; const float* vp = (idx < W) ? (cache + (size_t)idx * 1024 + 512) : (newb + (size_t)(idx - W) * cfg::NQKV + 1024);
        const float pv = (m < 64) ? __shfl(p0, m) : ((m < 128) ? __shfl(p1, m - 64) : __shfl(p2, 0));
        const f32x2g vv = *(const GAS f32x2g*)(vp + 2 * lane); o0 += pv * vv.x; o1 += pv * vv.y; }
    const float inv = 1.0f / sum; const size_t row = (size_t)cfg::MP + n * 8 + t;
    *(GAS unsigned*)(OG + ((size_t)g * cfg::MT + row) * 512 + h * 128 + 2 * lane) = cvtpk(o0 * inv, o1 * inv);
    if (lane == 0) LSE[((size_t)g * cfg::MT + row) * 4 + h] = mx + __logf(sum);
    LDS_WAIT(); asm volatile("" ::: "memory");
}

constexpr int MA_KSTR = 1040, MA_VSTR = 544, MA_BUF = 64 * MA_KSTR;
static_assert(2 * MA_BUF <= SCR_BYTES && 64 * MA_VSTR <= MA_BUF, "memory attention LDS");
__device__ __forceinline__ void memattn_unit(LAS unsigned char* lds, const bf16* Qb  , int row0  , bool sample  , const bf16* kbase  , const bf16* vbase, bf16* Ob  ) {
    int tid_ = threadIdx.x; asm volatile("" : "+v"(tid_));
    const int tid = tid_, lane = tid & 63, fr = lane & 15, fq = lane >> 4, wid = __builtin_amdgcn_readfirstlane(tid >> 6);
    const int qrow_i = sample ? row0 + (fr & 7) : row0 + wid * 16 + fr; const bool wr_ok = sample ? (wid == 0 && fr < 8) : true;
    bf16x8 qa[16];
#pragma unroll
    for (int ks = 0; ks < 16; ++ks) qa[ks] = *(const GAS bf16x8*)((const GAS char*)Qb + (unsigned)(qrow_i * 4096 + ks * 64 + fq * 16));
    f32x4 st[16]; bf16x8 pb[8]; f32x4 ot[16]; float inv = 1.f;
#pragma unroll
    for (int kt = 0; kt < 16; ++kt) st[kt] = (f32x4){0.f, 0.f, 0.f, 0.f};
    u32x4g pr[8];
    const unsigned vk = (unsigned)((tid >> 6) * 8192 + (tid & 63) * 16), vv = (unsigned)((tid >> 5) * 8192 + (tid & 31) * 16);
    const unsigned lk = (unsigned)((tid >> 6) * MA_KSTR + (tid & 63) * 16), lv = (unsigned)((tid >> 5) * MA_VSTR + (tid & 31) * 16);
#define MA_LOAD(c) do { if ((c) < 4) { const GAS char* src_ = (const GAS char*)(kbase + (size_t)((c) * 64) * 4096); _Pragma("unroll") for (int x8 = 0; x8 < 8; ++x8) pr[x8] = *(const GAS u32x4g*)(src_ + x8 * 65536 + vk); } \
        else { const GAS char* src_ = (const GAS char*)(vbase + (size_t)((((c) - 4) & 3) * 64) * 4096 + (((c) - 4) >> 2) * 256); _Pragma("unroll") for (int x8 = 0; x8 < 4; ++x8) pr[x8] = *(const GAS u32x4g*)(src_ + x8 * 131072 + vv); } } while (0)
#define MA_STORE(c) do { LAS unsigned char* dst_ = lds + ((c) & 1) * MA_BUF; if ((c) < 4) { _Pragma("unroll") for (int x8 = 0; x8 < 8; ++x8) *(LAS u32x4g*)(dst_ + x8 * 8 * MA_KSTR + lk) = pr[x8]; } \
        else { _Pragma("unroll") for (int x8 = 0; x8 < 4; ++x8) *(LAS u32x4g*)(dst_ + x8 * 16 * MA_VSTR + lv) = pr[x8]; } } while (0)
    MA_LOAD(0);
    const int q4 = fr >> 2, p4 = fr & 3;
#pragma unroll
    for (int c = 0; c < 12; ++c) {
        MA_STORE(c);
        __syncthreads();
        if (c < 11) MA_LOAD(c + 1);
        const LAS unsigned char* buf = lds + (c & 1) * MA_BUF;
        if (c < 4) {
#pragma unroll
            for (int k4 = 0; k4 < 4; ++k4)
#pragma unroll
                for (int ks = 0; ks < 16; ++ks) { const bf16x8 kf = *(const LAS bf16x8*)(buf + (16 * k4 + fr) * MA_KSTR + (32 * ks + 8 * fq) * 2); st[4 * c + k4] = mfma16(kf, qa[ks], st[4 * c + k4]); }
            if (c == 3) {
                float mx = -1e30f;
#pragma unroll
                for (int kt = 0; kt < 16; ++kt) mx = fmaxf(mx, fmaxf(fmaxf(st[kt][0], st[kt][1]), fmaxf(st[kt][2], st[kt][3])));
                mx = fmaxf(mx, __shfl_xor(mx, 16)); mx = fmaxf(mx, __shfl_xor(mx, 32));
                float s = 0.f;
#pragma unroll
                for (int kt = 0; kt < 16; ++kt)
#pragma unroll
                    for (int i = 0; i < 4; ++i) { const float p = exp2f(st[kt][i] - mx); st[kt][i] = p; s += p; }
                s += __shfl_xor(s, 16); s += __shfl_xor(s, 32); inv = 1.0f / s;
#pragma unroll
                for (int s2 = 0; s2 < 8; ++s2) { u32x4g w; w.x = cvtpk(st[2 * s2][0], st[2 * s2][1]); w.y = cvtpk(st[2 * s2][2], st[2 * s2][3]); w.z = cvtpk(st[2 * s2 + 1][0], st[2 * s2 + 1][1]); w.w = cvtpk(st[2 * s2 + 1][2], st[2 * s2 + 1][3]);
                    pb[s2] = __builtin_bit_cast(bf16x8, w); }
            }
        } else {
            const int kc = (c - 4) & 3, eh = (c - 4) >> 2;
            const LAS unsigned char* vb = buf + (4 * fq + q4) * MA_VSTR + p4 * 8;
#pragma unroll
            for (int s2 = 0; s2 < 2; ++s2)
#pragma unroll
                for (int ec = 0; ec < 16; ++ec) { const s16x4g v0 = ldtr(vb + (32 * s2) * MA_VSTR + ec * 32), v1 = ldtr(vb + (32 * s2 + 16) * MA_VSTR + ec * 32);
                    const bf16x8 vf = (bf16x8){v0[0], v0[1], v0[2], v0[3], v1[0], v1[1], v1[2], v1[3]};
                    ot[ec] = mfma16(vf, pb[2 * kc + s2], (kc == 0 && s2 == 0) ? (f32x4){0.f, 0.f, 0.f, 0.f} : ot[ec]); }
            if (kc == 3) {
                if (wr_ok) { GAS char* orow = (GAS char*)Ob + (unsigned)(qrow_i * 4096 + eh * 512 + fq * 8);
#pragma unroll
                    for (int ec = 0; ec < 16; ++ec) { u32x2g w; w.x = cvtpk(ot[ec][0] * inv, ot[ec][1] * inv); w.y = cvtpk(ot[ec][2] * inv, ot[ec][3] * inv); *(GAS u32x2g*)(orow + 32 * ec) = w; } }
            }
        }
    }
#undef MA_LOAD
#undef MA_STORE
    __syncthreads();
}
struct Args { const float* in[25]; float* out; unsigned char* ws; int ph_lo, ph_hi; };

struct SEpiF32 {
    float* dst; int ld; const LAS float* rs; float* out; int mode; int idx;
    __device__ __forceinline__ void operator()(int row, int col, f32x4 v, int lane) const {
        v = v * rs[row];
        *(GAS f32x4*)(dst + (size_t)row * ld + col) = v;
        const int n = row >> 3, t = row & 7;
        if (mode == 1) { const int g = col / 1536, rem = col - g * 1536, w = rem >> 9, c512 = rem & 511;
            if (w >= 1) { const int W = (g == 0) ? 128 : (g == 1 ? 512 : 2048); float* sw = out + (g == 0 ? cfg::O_SW0 : (g == 1 ? cfg::O_SW1 : cfg::O_SW2));
                *(GAS f32x4*)(sw + ((((size_t)(idx * 8 + n) * W + (W - 8 + t)) * 2 + (w - 1)) * 512) + c512) = v; } }
        else if (mode == 2) { if (t >= 6) *(GAS f32x4*)(out + cfg::O_SFC + ((size_t)(idx * 8 + n) * 2 + (t - 6)) * cfg::UP + col) = v; }
    }
};
struct SEpiBf16 {
    bf16* dst; int ld; const LAS float* rs; float scale;
    __device__ __forceinline__ void operator()(int row, int col, f32x4 v, int lane) const {
        v = v * (rs[row] * scale); u32x2g w; w.x = cvtpk(v[0], v[1]); w.y = cvtpk(v[2], v[3]); *(GAS u32x2g*)(dst + (size_t)row * ld + col) = w;
    }
};
struct SEpiResid {
    float* Y; bf16* YB; float* ssqs;
    __device__ __forceinline__ void operator()(int row, int col, f32x4 v, int lane) const {
        f32x4 y = *(const GAS f32x4*)(Y + (size_t)row * 2048 + col); y += v;
        *(GAS f32x4*)(Y + (size_t)row * 2048 + col) = y; u32x2g w; w.x = cvtpk(y[0], y[1]); w.y = cvtpk(y[2], y[3]); *(GAS u32x2g*)(YB + (size_t)row * 2048 + col) = w;
        float p = (y[0] * y[0] + y[1] * y[1]) + (y[2] * y[2] + y[3] * y[3]); p += __shfl_xor(p, 16); p += __shfl_xor(p, 32);
        if ((lane >> 4) == 0) ssqs[(size_t)row * 128 + (col >> 4)] = p;
    }
};

__global__ void __launch_bounds__(NTHREADS, 2) mk_fwd(Args args) {
    extern __shared__ __attribute__((aligned(16))) unsigned char lds_raw[];
    LAS unsigned char* lds = (LAS unsigned char*)lds_raw;
    volatile LAS unsigned* MISC = (volatile LAS unsigned*)(lds + MISC_OFF);
    const int G = gridDim.x, bx = blockIdx.x, NGW = G * NWAVES, NGT = G * NTHREADS;
    gu32* ctl = (gu32*)(args.ws + cfg::WS_CTL);
    for (int u = threadIdx.x; u < (LDS_BYTES - MISC_OFF) / 4; u += NTHREADS) ((LAS unsigned*)(lds + MISC_OFF))[u] = 0u;
    __syncthreads();
    XcdBarrier bar = xcd_barrier_post((unsigned*)ctl + 4096, MISC + 8);
    const int lo = args.ph_lo, hi = args.ph_hi; int ph = 0;
#define PH_ON (ph >= lo && ph < hi)
#define PH_END do { if (ph >= lo && ph + 1 < hi) xcd_barrier(bar); ++ph; } while (0)
#define PH_VARS int tid_ = threadIdx.x; asm volatile("" : "+v"(tid_)); const int tid = tid_, lane = tid & 63, wave = __builtin_amdgcn_readfirstlane(tid >> 6); \
    const int gw = bx * NWAVES + wave, gt = bx * NTHREADS + tid; (void)gw; (void)gt; (void)lane; \
    unsigned char* ws = args.ws; asm volatile("" : "+s"(ws)); float* out = args.out; asm volatile("" : "+s"(out)); (void)out;
#define Wqkv ((bf16*)(ws + cfg::WS_WQKV))
#define Woa ((bf16*)(ws + cfg::WS_WOA))
#define Winb ((bf16*)(ws + cfg::WS_WINB))
#define Wob ((bf16*)(ws + cfg::WS_WOB))
#define Wq ((bf16*)(ws + cfg::WS_WQ))
#define Wkv ((bf16*)(ws + cfg::WS_WKV))
#define Wo ((bf16*)(ws + cfg::WS_WO))
#define Wup ((bf16*)(ws + cfg::WS_WUP))
#define Wdn ((bf16*)(ws + cfg::WS_WDN))
#define Y ((float*)(ws + cfg::WS_Y))
#define YB ((bf16*)(ws + cfg::WS_YB))
#define SSQ ((float*)(ws + cfg::WS_SSQ))
#define SSQS ((float*)(ws + cfg::WS_SSQS))
#define MEMB ((bf16*)(ws + cfg::WS_MEMB))
#define SSQM ((float*)(ws + cfg::WS_SSQM))
#define KVB ((bf16*)(ws + cfg::WS_KVB))
#define CKV ((bf16*)(ws + cfg::WS_CKV))
#define BIG ((bf16*)(ws + cfg::WS_BIG))
#define ACT ((bf16*)(ws + cfg::WS_ACT))
#define QM ((bf16*)(ws + cfg::WS_QM))
#define OM ((bf16*)(ws + cfg::WS_OM))
#define OG ((bf16*)(ws + cfg::WS_OG))
#define LSE ((float*)(ws + cfg::WS_LSE))
#define MRG ((bf16*)(ws + cfg::WS_MRG))
#define QKVS ((float*)(ws + cfg::WS_QKVS))
#define U3S ((float*)(ws + cfg::WS_U3S))
#define US ((float*)(ws + cfg::WS_US))
#define Ys (Y + (size_t)cfg::MP * 2048)
#define YBs (YB + (size_t)cfg::MP * 2048)
    LAS float* const rstab = (LAS float*)(lds + 32768);

    if (PH_ON) { PH_VARS
        LAS float* scr = (LAS float*)(lds + wave * 16384);
        constexpr int I0 = 2 * 4608, I1 = 2 * 512, I2 = 2 * 6144, I3 = 2 * 2048, I4 = 4 * 2048, I5 = 4 * 4096, I6 = 4 * 2048, I7 = 4 * 11264, I8 = 4 * 5632;
        constexpr int NITEMS = I0 + I1 + I2 + I3 + I4 + I5 + I6 + I7 + I8;
        for (int it = gw; it < NITEMS; it += NGW) {
            int r = it;
            if (r < I0) { const int l = r / 4608, x = r % 4608; p0_transpose_item(args.in[14] + (size_t)l * 2048 * 4608, args.in[9] + (2 * l) * 2048, 2048, 4608, Wqkv + (size_t)l * 4608 * 2048, scr, x, lane); continue; } r -= I0;
            if (r < I1) { const int l = r / 512, x = r % 512; p0_transpose_item(args.in[15] + (size_t)l * 512 * 2048, nullptr, 512, 2048, Woa + (size_t)l * 2048 * 512, scr, x, lane); continue; } r -= I1;
            if (r < I2) { const int l = r / 6144, x = r % 6144; p0_transpose_item(args.in[16] + (size_t)l * 2048 * 6144, args.in[9] + (2 * l + 1) * 2048, 2048, 6144, Winb + (size_t)l * 6144 * 2048, scr, x, lane); continue; } r -= I2;
            if (r < I3) { const int l = r / 2048, x = r % 2048; p0_transpose_item(args.in[18] + (size_t)l * 2048 * 2048, nullptr, 2048, 2048, Wob + (size_t)l * 2048 * 2048, scr, x, lane); continue; } r -= I3;
            if (r < I4) { const int l = r / 2048, x = r % 2048; p0_transpose_item(args.in[19] + (size_t)l * 2048 * 2048, args.in[10] + l * 2048, 2048, 2048, Wq + (size_t)l * 2048 * 2048, scr, x, lane); continue; } r -= I4;
            if (r < I5) { const int l = r / 4096, x = r % 4096; p0_transpose_item(args.in[20] + (size_t)l * 2048 * 4096, args.in[11] + l * 2048, 2048, 4096, Wkv + (size_t)l * 4096 * 2048, scr, x, lane); continue; } r -= I5;
            if (r < I6) { const int l = r / 2048, x = r % 2048; p0_transpose_item(args.in[21] + (size_t)l * 2048 * 2048, nullptr, 2048, 2048, Wo + (size_t)l * 2048 * 2048, scr, x, lane); continue; } r -= I6;
            if (r < I7) { const int l = r / 11264, x = r % 11264; p0_transpose_item(args.in[22] + (size_t)l * 2048 * 11264, args.in[12] + l * 2048, 2048, 11264, Wup + (size_t)l * 11264 * 2048, scr, x, lane); continue; } r -= I7;
            { const int l = r / 5632, x = r % 5632; p0_transpose_item(args.in[24] + (size_t)l * 5632 * 2048, nullptr, 5632, 2048, Wdn + (size_t)l * 2048 * 5632, scr, x, lane); }
        }
        for (int m = gw; m < cfg::MT + cfg::MM; m += NGW) {
            if (m < cfg::MP) p0_row(args.in[0] + (size_t)m * 2048, Y + (size_t)m * 2048, YB + (size_t)m * 2048, SSQ + (size_t)m * 32, 32, lane);
            else if (m < cfg::MT) { const int s = m - cfg::MP; p0_row(args.in[1] + (size_t)s * 2048, Ys + (size_t)s * 2048, YBs + (size_t)s * 2048, SSQS + (size_t)s * 128, 128, lane); }
            else { const int s = m - cfg::MT; p0_row(args.in[2] + (size_t)s * 2048, nullptr, MEMB + (size_t)s * 2048, SSQM + (size_t)s * 32, 32, lane); }
        }
        { const GAS f32x4* src = (const GAS f32x4*)args.in[8]; GAS u32x2g* dst = (GAS u32x2g*)CKV; constexpr int NV = 4 * 8 * 256 * 4096 / 4;
          for (int i = gt; i < NV; i += NGT) { const f32x4 v = src[i]; u32x2g w; w.x = cvtpk(v.x, v.y); w.y = cvtpk(v.z, v.w); dst[i] = w; } }
#pragma unroll
        for (int g = 0; g < 3; ++g) { const int W = (g == 0) ? 128 : (g == 1 ? 512 : 2048); const int per = (W - 8) * 256;
            const float* cin = args.in[3 + g]; float* so = out + (g == 0 ? cfg::O_SW0 : (g == 1 ? cfg::O_SW1 : cfg::O_SW2));
            for (int i = gt; i < 16 * per; i += NGT) { const int jn = i / per, x = i - jn * per;
                ((GAS f32x4*)(so + (size_t)jn * W * 1024))[x] = ((const GAS f32x4*)(cin + ((size_t)jn * W + 8) * 1024))[x]; } }
    }
    PH_END;

    if (PH_ON) { PH_VARS
        pg8::Gemm g{MEMB, Wkv, cfg::MM, 16384, 2048}; pg8::StaticOrder S; S.init(cfg::MM, 16384, G, bx);
        ep::EpiKV E{KVB, SSQM, out};
        pg8::gemm_phase<ep::EpiKV, pg8::StaticOrder, true, true>(lds, g, S, E);
    }
    PH_END;

    for (int layer = 0; layer < 4; ++layer) {
        const int j = layer >> 1;
        if ((layer & 1) == 0) {
            if (PH_ON) { PH_VARS
                { pg8::Gemm g{YB, Wqkv + (size_t)j * 4608 * 2048, cfg::MP, cfg::NQKV, 2048}; pg8::StaticOrder S; S.init(cfg::MP, cfg::NQKV, G, bx);
                  ep::EpiQKV E{BIG, SSQ, out, j, 0.08838834764831845f * cfg::LOG2E};
                  pg8::gemm_phase<ep::EpiQKV, pg8::StaticOrder, true, true>(lds, g, S, E); }
                sample_rstd_table(rstab, SSQS);
                SEpiF32 se{QKVS, cfg::NQKV, rstab, out, 1, j};
                sample_gemm(lds, YBs, Wqkv + (size_t)j * 4608 * 2048, cfg::NQKV, 2048, bx, G, se);
            }
            PH_END;
            if (PH_ON) { PH_VARS
                for (int u = bx; u < 768; u += G) dattn_unit(lds, BIG, OG, LSE, u);
                for (int task = bx + G * wave; task < 768; task += G * NWAVES) dattn_sample((LAS float*)(lds + wave * 1024), QKVS, args.in[3], args.in[4], args.in[5], j, OG, LSE, task, lane);
            }
            PH_END;
            if (PH_ON) { PH_VARS
                for (int i = gt; i < cfg::MT * 64; i += NGT) { const int row = i >> 6, c8 = (i & 63) * 8, h = c8 >> 7;
                    const float l0 = LSE[((size_t)0 * cfg::MT + row) * 4 + h], l1 = LSE[((size_t)1 * cfg::MT + row) * 4 + h], l2 = LSE[((size_t)2 * cfg::MT + row) * 4 + h];
                    const float mx = fmaxf(l0, fmaxf(l1, l2)); float w0 = __expf(l0 - mx), w1 = __expf(l1 - mx), w2 = __expf(l2 - mx); const float inv = 1.0f / (w0 + w1 + w2); w0 *= inv; w1 *= inv; w2 *= inv;
                    const u32x4g a = *(const GAS u32x4g*)(OG + ((size_t)0 * cfg::MT + row) * 512 + c8), b = *(const GAS u32x4g*)(OG + ((size_t)1 * cfg::MT + row) * 512 + c8), c = *(const GAS u32x4g*)(OG + ((size_t)2 * cfg::MT + row) * 512 + c8);
                    u32x4g o;
                    o.x = cvtpk(w0 * bf_lo(a.x) + w1 * bf_lo(b.x) + w2 * bf_lo(c.x), w0 * bf_hi(a.x) + w1 * bf_hi(b.x) + w2 * bf_hi(c.x));
                    o.y = cvtpk(w0 * bf_lo(a.y) + w1 * bf_lo(b.y) + w2 * bf_lo(c.y), w0 * bf_hi(a.y) + w1 * bf_hi(b.y) + w2 * bf_hi(c.y));
                    o.z = cvtpk(w0 * bf_lo(a.z) + w1 * bf_lo(b.z) + w2 * bf_lo(c.z), w0 * bf_hi(a.z) + w1 * bf_hi(b.z) + w2 * bf_hi(c.z));
                    o.w = cvtpk(w0 * bf_lo(a.w) + w1 * bf_lo(b.w) + w2 * bf_lo(c.w), w0 * bf_hi(a.w) + w1 * bf_hi(b.w) + w2 * bf_hi(c.w));
                    *(GAS u32x4g*)(MRG + (size_t)row * 512 + c8) = o; }
            }
            PH_END;
            if (PH_ON) { PH_VARS
                { pg8::Gemm g{MRG, Woa + (size_t)j * 2048 * 512, cfg::MP, 2048, 512}; pg8::StaticOrder S; S.init(cfg::MP, 2048, G, bx);
                  ep::EpiResid E{Y, YB, SSQ};
                  pg8::gemm_phase<ep::EpiResid, pg8::StaticOrder, true, true>(lds, g, S, E); }
                SEpiResid se{Ys, YBs, SSQS};
                sample_gemm(lds, MRG + (size_t)cfg::MP * 512, Woa + (size_t)j * 2048 * 512, 2048, 512, bx, G, se);
            }
            PH_END;
        } else {
            if (PH_ON) { PH_VARS
                { pg8::Gemm g{YB, Winb + (size_t)j * 6144 * 2048, cfg::MP, cfg::NINB, 2048}; pg8::StaticOrder S; S.init(cfg::MP, cfg::NINB, G, bx);
                  ep::EpiScale E{BIG, cfg::NINB, SSQ, 1.f};
                  pg8::gemm_phase<ep::EpiScale, pg8::StaticOrder, true, true>(lds, g, S, E); }
                sample_rstd_table(rstab, SSQS);
                SEpiF32 se{U3S, cfg::NINB, rstab, out, 0, j};
                sample_gemm(lds, YBs, Winb + (size_t)j * 6144 * 2048, cfg::NINB, 2048, bx, G, se);
            }
            PH_END;
            if (PH_ON) { PH_VARS
                const float* cw = args.in[17] + (size_t)j * 3 * 2048;
                for (int i = gt; i < 512 * 256; i += NGT) { const int chunk = i >> 8, c8 = (i & 255) * 8, row0 = chunk * 16, t0 = row0 & 2047, nb = row0 >> 11;
                    float w0[8], w1[8], w2[8], p2[8], p1[8];
#pragma unroll
                    for (int e = 0; e < 8; ++e) { w0[e] = cw[c8 + e]; w1[e] = cw[2048 + c8 + e]; w2[e] = cw[4096 + c8 + e]; p2[e] = 0.f; p1[e] = 0.f; }
                    if (t0 != 0) { const bf16* rp = BIG + (size_t)(row0 - 2) * cfg::NINB + c8;
                        float g0[8], v0[8], g1[8], v1[8];
                        unpack8(g0, *(const GAS u32x4g*)(rp + 2048)); unpack8(v0, *(const GAS u32x4g*)(rp + 4096)); unpack8(g1, *(const GAS u32x4g*)(rp + cfg::NINB + 2048)); unpack8(v1, *(const GAS u32x4g*)(rp + cfg::NINB + 4096));
#pragma unroll
                        for (int e = 0; e < 8; ++e) { p2[e] = g0[e] * v0[e]; p1[e] = g1[e] * v1[e]; } }
                    for (int q = 0; q < 16; ++q) { const int row = row0 + q, t = t0 + q; const bf16* rp = BIG + (size_t)row * cfg::NINB + c8;
                        const u32x4g gb = *(const GAS u32x4g*)rp, gc = *(const GAS u32x4g*)(rp + 2048), vl = *(const GAS u32x4g*)(rp + 4096);
                        float cv[8], gbf[8], o[8], gcf[8], vlf[8];
                        unpack8(gbf, gb); unpack8(gcf, gc); unpack8(vlf, vl);
#pragma unroll
                        for (int e = 0; e < 8; ++e) cv[e] = gcf[e] * vlf[e];
#pragma unroll
                        for (int e = 0; e < 8; ++e) { o[e] = gbf[e] * (w0[e] * p2[e] + w1[e] * p1[e] + w2[e] * cv[e]); p2[e] = p1[e]; p1[e] = cv[e]; }
                        u32x4g w; w.x = cvtpk(o[0], o[1]); w.y = cvtpk(o[2], o[3]); w.z = cvtpk(o[4], o[5]); w.w = cvtpk(o[6], o[7]);
                        *(GAS u32x4g*)(MRG + (size_t)row * 2048 + c8) = w;
                        if (t >= 2046) { float* d = out + cfg::O_PCB + ((size_t)(j * 4 + nb) * 2 + (t - 2046)) * 2048 + c8;
                            *(GAS f32x4*)d = (f32x4){cv[0], cv[1], cv[2], cv[3]}; *(GAS f32x4*)(d + 4) = (f32x4){cv[4], cv[5], cv[6], cv[7]}; } } }
                for (int i = gt; i < 8 * 512; i += NGT) { const int n = i >> 9, c4 = (i & 511) * 4;
                    const f32x4 w0 = *(const GAS f32x4*)(cw + c4), w1 = *(const GAS f32x4*)(cw + 2048 + c4), w2 = *(const GAS f32x4*)(cw + 4096 + c4);
                    const float* st = args.in[6] + ((size_t)(j * 8 + n) * 2) * 2048 + c4;
                    f32x4 p2 = *(const GAS f32x4*)st, p1 = *(const GAS f32x4*)(st + 2048);
                    for (int t = 0; t < 8; ++t) { const float* rp = U3S + (size_t)(n * 8 + t) * cfg::NINB + c4;
                        const f32x4 gb = *(const GAS f32x4*)rp, gc = *(const GAS f32x4*)(rp + 2048), vl = *(const GAS f32x4*)(rp + 4096);
                        const f32x4 cv = gc * vl; const f32x4 o = gb * (w0 * p2 + w1 * p1 + w2 * cv); p2 = p1; p1 = cv;
                        u32x2g w; w.x = cvtpk(o[0], o[1]); w.y = cvtpk(o[2], o[3]); *(GAS u32x2g*)(MRG + (size_t)(cfg::MP + n * 8 + t) * 2048 + c4) = w;
                        if (t >= 6) *(GAS f32x4*)(out + cfg::O_SCB + ((size_t)(j * 8 + n) * 2 + (t - 6)) * 2048 + c4) = cv; } }
            }
            PH_END;
            if (PH_ON) { PH_VARS
                { pg8::Gemm g{MRG, Wob + (size_t)j * 2048 * 2048, cfg::MP, 2048, 2048}; pg8::StaticOrder S; S.init(cfg::MP, 2048, G, bx);
                  ep::EpiResid E{Y, YB, SSQ};
                  pg8::gemm_phase<ep::EpiResid, pg8::StaticOrder, true, true>(lds, g, S, E); }
                SEpiResid se{Ys, YBs, SSQS};
                sample_gemm(lds, MRG + (size_t)cfg::MP * 2048, Wob + (size_t)j * 2048 * 2048, 2048, 2048, bx, G, se);
            }
            PH_END;
        }
        if (PH_ON) { PH_VARS
            const float qs = 0.04419417382415922f * cfg::LOG2E;
            { pg8::Gemm g{YB, Wq + (size_t)layer * 2048 * 2048, cfg::MP, 2048, 2048}; pg8::StaticOrder S; S.init(cfg::MP, 2048, G, bx);
              ep::EpiScale E{QM, 2048, SSQ, qs};
              pg8::gemm_phase<ep::EpiScale, pg8::StaticOrder, true, true>(lds, g, S, E); }
            sample_rstd_table(rstab, SSQS);
            SEpiBf16 se{QM + (size_t)cfg::MP * 2048, 2048, rstab, qs};
            sample_gemm(lds, YBs, Wq + (size_t)layer * 2048 * 2048, 2048, 2048, bx, G, se);
        }
        PH_END;
        if (PH_ON) { PH_VARS
            for (int u = bx; u < 256 + 32; u += G) {
                if (u < 256) { const int n = u >> 6, h = (u >> 4) & 3, qb = u & 15;
                    const bf16* kb = KVB + ((size_t)layer * cfg::MM + n * 256) * 4096 + h * 512;
                    memattn_unit(lds, QM + h * 512, n * 2048 + qb * 128, false, kb, kb + 2048, OM + h * 512); }
                else { const int s = u - 256, n = s >> 2, h = s & 3;
                    const bf16* kb = CKV + ((size_t)(layer * 8 + n) * 256) * 4096 + h * 512;
                    memattn_unit(lds, QM + h * 512, cfg::MP + n * 8, true, kb, kb + 2048, OM + h * 512); }
            }
        }
        PH_END;
        if (PH_ON) { PH_VARS
            { pg8::Gemm g{OM, Wo + (size_t)layer * 2048 * 2048, cfg::MP, 2048, 2048}; pg8::StaticOrder S; S.init(cfg::MP, 2048, G, bx);
              ep::EpiResid E{Y, YB, SSQ};
              pg8::gemm_phase<ep::EpiResid, pg8::StaticOrder, true, true>(lds, g, S, E); }
            SEpiResid se{Ys, YBs, SSQS};
            sample_gemm(lds, OM + (size_t)cfg::MP * 2048, Wo + (size_t)layer * 2048 * 2048, 2048, 2048, bx, G, se);
        }
        PH_END;
        if (PH_ON) { PH_VARS
            { pg8::Gemm g{YB, Wup + (size_t)layer * 11264 * 2048, cfg::MP, cfg::UP, 2048}; pg8::StaticOrder S; S.init(cfg::MP, cfg::UP, G, bx);
              ep::EpiUp E{BIG, SSQ, out, layer};
              pg8::gemm_phase<ep::EpiUp, pg8::StaticOrder, true, true>(lds, g, S, E); }
            sample_rstd_table(rstab, SSQS);
            SEpiF32 se{US, cfg::UP, rstab, out, 2, layer};
            sample_gemm(lds, YBs, Wup + (size_t)layer * 11264 * 2048, cfg::UP, 2048, bx, G, se);
        }
        PH_END;
        if (PH_ON) { PH_VARS
            const float* cw = args.in[23] + (size_t)layer * 3 * cfg::UP;
            for (int i = gt; i < 512 * 704; i += NGT) { const int chunk = i / 704, c8 = (i - chunk * 704) * 8, row0 = chunk * 16, t0 = row0 & 2047;
                float wa0[8], wa1[8], wa2[8], wb0[8], wb1[8], wb2[8], a2[8], a1[8], b2[8], b1[8];
#pragma unroll
                for (int e = 0; e < 8; ++e) { wa0[e] = cw[c8 + e]; wa1[e] = cw[cfg::UP + c8 + e]; wa2[e] = cw[2 * cfg::UP + c8 + e];
                    wb0[e] = cw[cfg::DFF + c8 + e]; wb1[e] = cw[cfg::UP + cfg::DFF + c8 + e]; wb2[e] = cw[2 * cfg::UP + cfg::DFF + c8 + e]; a2[e] = 0.f; a1[e] = 0.f; b2[e] = 0.f; b1[e] = 0.f; }
                if (t0 != 0) { const bf16* rp = BIG + (size_t)(row0 - 2) * cfg::UP + c8;
                    unpack8(a2, *(const GAS u32x4g*)rp); unpack8(b2, *(const GAS u32x4g*)(rp + cfg::DFF)); unpack8(a1, *(const GAS u32x4g*)(rp + cfg::UP)); unpack8(b1, *(const GAS u32x4g*)(rp + cfg::UP + cfg::DFF)); }
                for (int q = 0; q < 16; ++q) { const int row = row0 + q; const bf16* rp = BIG + (size_t)row * cfg::UP + c8; const u32x4g ua = *(const GAS u32x4g*)rp, ub = *(const GAS u32x4g*)(rp + cfg::DFF);
                    float ca[8], cb[8], o[8];
                    unpack8(ca, ua); unpack8(cb, ub);
#pragma unroll
                    for (int e = 0; e < 8; ++e) { const float va = wa0[e] * a2[e] + wa1[e] * a1[e] + wa2[e] * ca[e], vb = wb0[e] * b2[e] + wb1[e] * b1[e] + wb2[e] * cb[e];
                        o[e] = va / (1.0f + __expf(-va)) * vb; a2[e] = a1[e]; a1[e] = ca[e]; b2[e] = b1[e]; b1[e] = cb[e]; }
                    u32x4g w; w.x = cvtpk(o[0], o[1]); w.y = cvtpk(o[2], o[3]); w.z = cvtpk(o[4], o[5]); w.w = cvtpk(o[6], o[7]);
                    *(GAS u32x4g*)(ACT + (size_t)row * cfg::DFF + c8) = w; } }
            for (int i = gt; i < 8 * 1408; i += NGT) { const int n = i / 1408, c4 = (i - n * 1408) * 4;
                const f32x4 wa0 = *(const GAS f32x4*)(cw + c4), wa1 = *(const GAS f32x4*)(cw + cfg::UP + c4), wa2 = *(const GAS f32x4*)(cw + 2 * cfg::UP + c4);
                const f32x4 wb0 = *(const GAS f32x4*)(cw + cfg::DFF + c4), wb1 = *(const GAS f32x4*)(cw + cfg::UP + cfg::DFF + c4), wb2 = *(const GAS f32x4*)(cw + 2 * cfg::UP + cfg::DFF + c4);
                const float* st = args.in[7] + ((size_t)(layer * 8 + n) * 2) * cfg::UP + c4;
                f32x4 a2 = *(const GAS f32x4*)st, a1 = *(const GAS f32x4*)(st + cfg::UP), b2 = *(const GAS f32x4*)(st + cfg::DFF), b1 = *(const GAS f32x4*)(st + cfg::UP + cfg::DFF);
                for (int t = 0; t < 8; ++t) { const float* rp = US + (size_t)(n * 8 + t) * cfg::UP + c4; const f32x4 ca = *(const GAS f32x4*)rp, cb = *(const GAS f32x4*)(rp + cfg::DFF);
                    const f32x4 va = wa0 * a2 + wa1 * a1 + wa2 * ca, vb = wb0 * b2 + wb1 * b1 + wb2 * cb; a2 = a1; a1 = ca; b2 = b1; b1 = cb;
                    f32x4 o; o[0] = va[0] / (1.0f + __expf(-va[0])) * vb[0]; o[1] = va[1] / (1.0f + __expf(-va[1])) * vb[1]; o[2] = va[2] / (1.0f + __expf(-va[2])) * vb[2]; o[3] = va[3] / (1.0f + __expf(-va[3])) * vb[3];
                    u32x2g w; w.x = cvtpk(o[0], o[1]); w.y = cvtpk(o[2], o[3]); *(GAS u32x2g*)(ACT + (size_t)(cfg::MP + n * 8 + t) * cfg::DFF + c4) = w; } }
        }
        PH_END;
        if (PH_ON) { PH_VARS
            { pg8::Gemm g{ACT, Wdn + (size_t)layer * 2048 * 5632, cfg::MP, 2048, cfg::DFF}; pg8::StaticOrder S; S.init(cfg::MP, 2048, G, bx);
              ep::EpiResid E{Y, YB, SSQ};
              pg8::gemm_phase<ep::EpiResid, pg8::StaticOrder, true, true>(lds, g, S, E); }
            SEpiResid se{Ys, YBs, SSQS};
            sample_gemm(lds, ACT + (size_t)cfg::MP * cfg::DFF, Wdn + (size_t)layer * 2048 * 5632, 2048, cfg::DFF, bx, G, se);
        }
        PH_END;
    }
    if (PH_ON) { PH_VARS
        const float* gf = args.in[13];
        for (int m = gw; m < cfg::MT; m += NGW) { const GAS f32x4* yr = (const GAS f32x4*)(Y + (size_t)m * 2048) + lane; f32x4 v[8]; float s = 0.f;
#pragma unroll
            for (int q = 0; q < 8; ++q) { v[q] = yr[64 * q]; s += (v[q].x * v[q].x + v[q].y * v[q].y) + (v[q].z * v[q].z + v[q].w * v[q].w); }
            const float rs = 1.0f / sqrtf(wave_sum(s) * (1.0f / 2048.0f) + cfg::EPS);
            GAS f32x4* o = (GAS f32x4*)(out + (m < cfg::MP ? cfg::O_YP + (size_t)m * 2048 : cfg::O_YS + (size_t)(m - cfg::MP) * 2048)) + lane;
#pragma unroll
            for (int q = 0; q < 8; ++q) { const f32x4 gg = ((const GAS f32x4*)gf)[lane + 64 * q]; o[64 * q] = v[q] * rs * gg; } }
    }
#undef PH_ON
#undef PH_END
#undef PH_VARS
#undef Wqkv
#undef Woa
#undef Winb
#undef Wob
#undef Wq
#undef Wkv
#undef Wo
#undef Wup
#undef Wdn
#undef Y
#undef YB
#undef SSQ
#undef SSQS
#undef MEMB
#undef SSQM
#undef KVB
#undef CKV
#undef BIG
#undef ACT
#undef QM
#undef OM
#undef OG
#undef LSE
#undef MRG
#undef QKVS
#undef U3S
#undef US
#undef Ys
#undef YBs
}

#ifndef MK_CUTS
#define MK_CUTS 0
#endif
extern "C" void kernel_launch(void* const* d_in, const int* in_sizes, int n_in, void* d_out, int out_size, void* d_ws, size_t ws_size, hipStream_t stream) {
    static int grid = 0;
    if (grid == 0) {
        if (n_in != 25 || (size_t)out_size != cfg::O_END || ws_size < cfg::WS_END) { fprintf(stderr, "kernel_launch: unexpected problem: n_in %d out %d ws %zu (need %zu)\n", n_in, out_size, ws_size, (size_t)cfg::WS_END); grid = -1; return; }
        int dev = 0, cus = 0, per_cu = 0;
        if (hipGetDevice(&dev) != hipSuccess || hipDeviceGetAttribute(&cus, hipDeviceAttributeMultiprocessorCount, dev) != hipSuccess) { grid = -1; return; }
        if (hipFuncSetAttribute((const void*)mk_fwd, hipFuncAttributeMaxDynamicSharedMemorySize, LDS_BYTES) != hipSuccess) { fprintf(stderr, "kernel_launch: hipFuncSetAttribute failed\n"); grid = -1; return; }
        if (hipOccupancyMaxActiveBlocksPerMultiprocessor(&per_cu, (const void*)mk_fwd, NTHREADS, LDS_BYTES) != hipSuccess || per_cu < 1) { fprintf(stderr, "kernel_launch: occupancy query says %d\n", per_cu); }
        (void)hipGetLastError();
        grid = cus;
    }
    if (grid < 0) return;
    (void)hipMemsetAsync((char*)d_ws + cfg::WS_CTL, 0, cfg::CTL_ZERO_BYTES, stream);
    Args a{};
    for (int i = 0; i < 25; ++i) a.in[i] = (const float*)d_in[i];
    a.out = (float*)d_out; a.ws = (unsigned char*)d_ws;
#if MK_CUTS == 0
    a.ph_lo = 0; a.ph_hi = 1000;
    hipLaunchKernelGGL(mk_fwd, dim3(grid), dim3(NTHREADS), LDS_BYTES, stream, a);
#else
    for (int p = 0; p < 2 + 2 * 10 + 2 * 9 + 1; ++p) { a.ph_lo = p; a.ph_hi = p + 1; hipLaunchKernelGGL(mk_fwd, dim3(grid), dim3(NTHREADS), LDS_BYTES, stream, a); }
#endif
}
```

```cpp
#include <hip/hip_runtime.h>
#include <cstdio>
#include <cstdint>
namespace pg8 {
#define PG8_LAS __attribute__((address_space(3)))
typedef unsigned short bf16_t;
typedef short bf16x8 __attribute__((ext_vector_type(8)));
typedef float f32x4 __attribute__((ext_vector_type(4)));
typedef unsigned u32x4 __attribute__((ext_vector_type(4)));
constexpr int BM = 256, BK = 64, HALF = 128, HTB = HALF * BK * 2  , STAGE_BYTES = 8 * HTB, NXCD = 8, WGM = 4;

__host__ __device__ __forceinline__ int lds_byte(int r, int c) { const int st = (r >> 4) * 2 + (c >> 5), rr = r & 15, cc = c & 31, ob = rr * 64 + cc * 2; return st * 1024 + (ob ^ (((ob >> 9) & 1) << 5)); }
__host__ __device__ __forceinline__ void stage_rc(int b, int& R, int& C) { const int st = b / 1024, sb = b % 1024, swz = sb ^ (((sb >> 9) & 1) << 5); R = (st >> 1) * 16 + swz / 64; C = (st & 1) * 32 + (swz % 64) / 2; }
__host__ __device__ __forceinline__ int perm32(int rho) { const int n = rho >> 4, i = rho & 15; return 8 * (i >> 2) + 4 * n + (i & 3); }

struct Unit { int pm, pn, z; };
struct Gemm { const bf16_t* A; const bf16_t* Bt; int M, N, K; int lda = 0, ldb = 0; };

struct StaticOrder {
    int nM, nN, nwg, G, c, wgm;
    __host__ __device__ void init(int M, int N, int G_, int c_, int wgm_ = WGM) { nM = M / BM; nN = N / BM; nwg = nM * nN; G = G_; c = c_; wgm = wgm_; }
    __host__ __device__ bool next(int i, Unit& u) const {
        const long L = (long)i * G + c; if (L >= nwg) return false;
        int wgid = (int)L; { const int q = nwg / NXCD, r = nwg % NXCD, xcd = wgid % NXCD, off = wgid / NXCD; wgid = (xcd < r ? xcd * (q + 1) : r * (q + 1) + (xcd - r) * q) + off; }
        const int nig = wgm * nN, gid = wgid / nig, fm = gid * wgm, gsz = (nM - fm) < wgm ? (nM - fm) : wgm;
        u.pm = fm + ((wgid % nig) % gsz); u.pn = (wgid % nig) / gsz; u.z = 0; return true;
    }
    __device__ __forceinline__ void a_ready(const Unit&) const {}
    __device__ __forceinline__ void done(const Unit&) const {}
    __device__ __forceinline__ const char* abase(const Gemm& g, const Unit& u) const { return (const char*)g.A + (size_t)u.pm * BM * (g.lda ? g.lda : g.K) * 2; }
    __device__ __forceinline__ const char* bbase(const Gemm& g, const Unit& u) const { return (const char*)g.Bt + (size_t)u.pn * BM * (g.ldb ? g.ldb : g.K) * 2; }
};

__device__ __forceinline__ unsigned cvt_pk_bf16(float lo, float hi) { unsigned r; asm volatile("v_cvt_pk_bf16_f32 %0, %1, %2" : "=v"(r) : "v"(lo), "v"(hi)); return r; }
typedef float f32x2 __attribute__((ext_vector_type(2)));
__device__ __forceinline__ void ep_rstd_table(const float* ssq, PG8_LAS float* rt, int pm, int tid);
template <class Epi, class Sched, bool ALIGN_EPI = false, bool SP2 = false>
__device__ __forceinline__ void gemm_phase(PG8_LAS unsigned char* lds, const Gemm g, const Sched& S, const Epi& E) {
    int tid_ = threadIdx.x; asm volatile("" : "+v"(tid_));
    const int tid = tid_, wid = __builtin_amdgcn_readfirstlane(tid >> 6), lane = tid & 63, wr = wid >> 2, wc = wid & 3, fr = lane & 15, fq = lane >> 4;
    const int K = g.K, nt = K / BK, lda = g.lda ? g.lda : K, ldb = g.ldb ? g.ldb : K;
    unsigned voffA[2], voffB[2];
#pragma unroll
    for (int i = 0; i < 2; ++i) { int R, C; stage_rc(tid * 16 + i * 8192, R, C); const int Rb = Epi::PERM ? ((R & ~31) + perm32(R & 31)) : R;
        voffA[i] = (unsigned)(R * lda + C) * 2u; voffB[i] = (unsigned)(Rb * ldb + C) * 2u; }
    const size_t kstep = (size_t)(BK * 2);
    const size_t hstepA = (size_t)HALF * lda * 2, hstepB = (size_t)HALF * ldb * 2;
    const unsigned ldsw = (unsigned)wid * 1024u;
    const int aoff = lds_byte(wr * 64 + fr, fq * 8), boff = lds_byte(wc * 32 + fr, fq * 8);
#define PG8_SA(b, h) (((b) * 2 + (h)) * HTB)
#define PG8_SB(b, h) ((4 + (b) * 2 + (h)) * HTB)
#define PG8_STAGE(bufoff, gbase, voff) do { _Pragma("unroll") for (int _i = 0; _i < 2; ++_i) \
        __builtin_amdgcn_global_load_lds((const unsigned*)((const char*)(gbase) + (voff)[_i]), (PG8_LAS unsigned*)(lds + (bufoff) + ldsw + _i * 8192), 16, 0, 0); } while (0)
#define PG8_LDA(dst, b, h) do { _Pragma("unroll") for (int m = 0; m < 4; ++m) _Pragma("unroll") for (int k = 0; k < 2; ++k) dst[m][k] = *(const PG8_LAS bf16x8*)(lds + PG8_SA(b, h) + aoff + m * 2048 + k * 1024); } while (0)
#define PG8_LDB(dst, b, h) do { _Pragma("unroll") for (int n = 0; n < 2; ++n) _Pragma("unroll") for (int k = 0; k < 2; ++k) dst[n][k] = *(const PG8_LAS bf16x8*)(lds + PG8_SB(b, h) + boff + n * 2048 + k * 1024); } while (0)
#define PG8_MMA(ai, bj, At, Bt) do { __builtin_amdgcn_s_setprio(1); _Pragma("unroll") for (int m = 0; m < 4; ++m) _Pragma("unroll") for (int n = 0; n < 2; ++n) _Pragma("unroll") for (int k = 0; k < 2; ++k) \
        acc[ai][bj][m][n] = __builtin_amdgcn_mfma_f32_16x16x32_bf16(Bt[n][k], At[m][k], acc[ai][bj][m][n], 0, 0, 0); __builtin_amdgcn_s_setprio(0); } while (0)
#define PG8_WAIT_V(n) asm volatile("s_waitcnt vmcnt(" #n ")" ::: "memory")
#define PG8_WAIT_L(n) asm volatile("s_waitcnt lgkmcnt(" #n ")" ::: "memory")
#define PG8_BAR __builtin_amdgcn_s_barrier()
#define PG8_SCHED __builtin_amdgcn_sched_barrier(0)
    Unit cur, nxt; int ui = 0;
    if (!S.next(0, cur)) return;
    f32x4 acc[2][2][4][2];
#pragma unroll
    for (int a = 0; a < 2; ++a)
#pragma unroll
        for (int b = 0; b < 2; ++b)
#pragma unroll
            for (int m = 0; m < 4; ++m)
#pragma unroll
                for (int n = 0; n < 2; ++n) acc[a][b][m][n] = (f32x4){0.f, 0.f, 0.f, 0.f};
    constexpr bool HAS_INIT = Epi::ACC_INIT;
    bf16x8 At[4][2], B0[2][2], B1[2][2];
    const char* cA = S.abase(g, cur); const char* cB = S.bbase(g, cur);
    S.a_ready(cur);
    if constexpr (Epi::RSTD) ep_rstd_table(E.ssq, E.rt, cur.pm, tid);
    if constexpr (SP2) {
        PG8_STAGE(PG8_SB(0, 0), cB, voffB); PG8_STAGE(PG8_SB(0, 1), cB + hstepB, voffB); PG8_STAGE(PG8_SA(0, 0), cA, voffA); PG8_STAGE(PG8_SA(0, 1), cA + hstepA, voffA);
        if constexpr (HAS_INIT) E.init(acc, cur, wr, wc, fr, fq);
        if (wr == 1) PG8_BAR;
        PG8_WAIT_V(2); PG8_BAR;
        PG8_STAGE(PG8_SB(1, 0), cB + kstep, voffB); PG8_STAGE(PG8_SA(1, 0), cA + kstep, voffA); PG8_STAGE(PG8_SB(1, 1), cB + hstepB + kstep, voffB);
        PG8_WAIT_V(6); PG8_BAR;
    } else {
        PG8_STAGE(PG8_SB(0, 0), cB, voffB); PG8_STAGE(PG8_SA(0, 0), cA, voffA); PG8_STAGE(PG8_SB(0, 1), cB + hstepB, voffB); PG8_STAGE(PG8_SA(0, 1), cA + hstepA, voffA);
        if (wr == 1) PG8_BAR;
        PG8_WAIT_V(4); PG8_BAR;
        PG8_STAGE(PG8_SB(1, 0), cB + kstep, voffB); PG8_STAGE(PG8_SA(1, 0), cA + kstep, voffA); PG8_STAGE(PG8_SB(1, 1), cB + hstepB + kstep, voffB);
        PG8_WAIT_V(6); PG8_BAR;
    }
    for (;;) {
        const bool has_next = S.next(ui + 1, nxt);
        const char* nA = has_next ? S.abase(g, nxt) : cA; const char* nB = has_next ? S.bbase(g, nxt) : cB;
        for (int t = 0; t < nt; t += 2) {
            const bool last = (t == nt - 2);
            const char* a1 = cA + (size_t)(t + 1) * kstep;
            const char* a2 = last ? nA : cA + (size_t)(t + 2) * kstep; const char* b2 = last ? nB : cB + (size_t)(t + 2) * kstep;
            const char* a3 = a2 + kstep; const char* b3 = b2 + kstep;
            if (last && has_next) S.a_ready(nxt);
            if constexpr (SP2) {
            PG8_LDB(B0, 0, 0); PG8_LDB(B1, 0, 1); PG8_SCHED; PG8_LDA(At, 0, 0); PG8_STAGE(PG8_SA(1, 1), a1 + hstepA, voffA);
            PG8_WAIT_V(8); PG8_WAIT_L(0); PG8_BAR; PG8_MMA(0, 0, At, B0); PG8_MMA(0, 1, At, B1); PG8_BAR; PG8_SCHED;
            PG8_LDA(At, 0, 1); PG8_STAGE(PG8_SB(0, 0), b2, voffB); PG8_STAGE(PG8_SB(0, 1), b2 + hstepB, voffB); PG8_STAGE(PG8_SA(0, 0), a2, voffA);
            PG8_WAIT_V(8); PG8_WAIT_L(0); PG8_BAR; PG8_MMA(1, 0, At, B0); PG8_MMA(1, 1, At, B1); PG8_BAR; PG8_SCHED;
            PG8_LDB(B0, 1, 0); PG8_LDB(B1, 1, 1); PG8_SCHED; PG8_LDA(At, 1, 0); PG8_STAGE(PG8_SA(0, 1), a2 + hstepA, voffA);
            PG8_WAIT_V(8); PG8_WAIT_L(0); PG8_BAR; PG8_MMA(0, 0, At, B0); PG8_MMA(0, 1, At, B1); PG8_BAR; PG8_SCHED;
            PG8_LDA(At, 1, 1); PG8_STAGE(PG8_SB(1, 0), b3, voffB); PG8_STAGE(PG8_SB(1, 1), b3 + hstepB, voffB); PG8_STAGE(PG8_SA(1, 0), a3, voffA);
            PG8_WAIT_V(8); PG8_WAIT_L(0); PG8_BAR; PG8_MMA(1, 0, At, B0); PG8_MMA(1, 1, At, B1); PG8_BAR; PG8_SCHED;
            } else {
            PG8_LDB(B0, 0, 0); PG8_SCHED; PG8_LDA(At, 0, 0); PG8_STAGE(PG8_SA(1, 1), a1 + hstepA, voffA);
            PG8_WAIT_L(8); PG8_BAR; PG8_WAIT_L(0); PG8_MMA(0, 0, At, B0); PG8_BAR; PG8_SCHED;
            PG8_LDB(B1, 0, 1); PG8_STAGE(PG8_SB(0, 0), b2, voffB);
            PG8_BAR; PG8_WAIT_L(0); PG8_MMA(0, 1, At, B1); PG8_BAR;
            PG8_LDA(At, 0, 1); PG8_STAGE(PG8_SA(0, 0), a2, voffA);
            PG8_BAR; PG8_WAIT_L(0); PG8_MMA(1, 0, At, B0); PG8_BAR; PG8_SCHED;
            PG8_STAGE(PG8_SB(0, 1), b2 + hstepB, voffB);
            PG8_WAIT_V(6); PG8_BAR; PG8_MMA(1, 1, At, B1); PG8_BAR;
            PG8_LDB(B0, 1, 0); PG8_SCHED; PG8_LDA(At, 1, 0); PG8_STAGE(PG8_SA(0, 1), a2 + hstepA, voffA);
            PG8_WAIT_L(8); PG8_BAR; PG8_WAIT_L(0); PG8_MMA(0, 0, At, B0); PG8_BAR; PG8_SCHED;
            PG8_LDB(B1, 1, 1); PG8_STAGE(PG8_SB(1, 0), b3, voffB);
            PG8_BAR; PG8_WAIT_L(0); PG8_MMA(0, 1, At, B1); PG8_BAR;
            PG8_LDA(At, 1, 1); PG8_STAGE(PG8_SA(1, 0), a3, voffA);
            PG8_BAR; PG8_WAIT_L(0); PG8_MMA(1, 0, At, B0); PG8_BAR; PG8_SCHED;
            PG8_STAGE(PG8_SB(1, 1), b3 + hstepB, voffB);
            PG8_WAIT_V(6); PG8_BAR; PG8_MMA(1, 1, At, B1); PG8_BAR;
            }
        }
        if constexpr (ALIGN_EPI) { if (wr == 0) PG8_BAR; }
        if constexpr (!Epi::AFTER_DRAIN) { E(acc, cur, wr, wc, fr, fq); S.done(cur); }
        if (!has_next) break;
        if constexpr (Epi::RSTD) { if (nxt.pm != cur.pm) { asm volatile("s_waitcnt lgkmcnt(0)" ::: "memory"); PG8_BAR; int t2_ = tid; asm volatile("" : "+v"(t2_)); ep_rstd_table(E.ssq, E.rt, nxt.pm, t2_); } }
        if constexpr (HAS_INIT) E.init(acc, nxt, wr, wc, fr, fq); else
#pragma unroll
        for (int a = 0; a < 2; ++a)
#pragma unroll
            for (int b = 0; b < 2; ++b)
#pragma unroll
                for (int m = 0; m < 4; ++m)
#pragma unroll
                    for (int n = 0; n < 2; ++n) acc[a][b][m][n] = (f32x4){0.f, 0.f, 0.f, 0.f};
        cur = nxt; cA = nA; cB = nB; ++ui;
        if constexpr (ALIGN_EPI) { if (wr == 1) PG8_BAR; }
    }
    PG8_WAIT_V(0);
    if constexpr (!ALIGN_EPI) { if (wr == 0) PG8_BAR; }
    PG8_BAR;
    if constexpr (Epi::AFTER_DRAIN) { E.fused(acc, cur, wr, wc, fr, fq, lds, wid, lane); S.done(cur); }
#undef PG8_SA
#undef PG8_SB
#undef PG8_STAGE
#undef PG8_LDA
#undef PG8_LDB
#undef PG8_MMA
#undef PG8_WAIT_V
#undef PG8_WAIT_L
#undef PG8_BAR
#undef PG8_SCHED
}
}
namespace cfg {
constexpr int D = 2048, BATCH = 4, SEQ = 2048, DEPTH = 4, DB = 8, DS = 8, NMEM = 256, DFF = 5632, UP = 2 * DFF;
constexpr int MP = BATCH * SEQ, MS = DB * DS, MT = MP + MS, MM = BATCH * NMEM;
constexpr int NQKV = 4608, NINB = 6144;
constexpr float EPS = 1e-6f;
constexpr float LOG2E = 1.4426950408889634f, LN2 = 0.6931471805599453f;
constexpr size_t O_YP = 0;
constexpr size_t O_YS = O_YP + (size_t)BATCH * SEQ * D;
constexpr size_t O_PW0 = O_YS + (size_t)DB * DS * D;
constexpr size_t O_PW1 = O_PW0 + (size_t)2 * BATCH * 128 * 1024;
constexpr size_t O_PW2 = O_PW1 + (size_t)2 * BATCH * 512 * 1024;
constexpr size_t O_PCB = O_PW2 + (size_t)2 * BATCH * 2048 * 1024;
constexpr size_t O_PFC = O_PCB + (size_t)2 * BATCH * 2 * D;
constexpr size_t O_PMK = O_PFC + (size_t)DEPTH * BATCH * 2 * UP;
constexpr size_t O_SW0 = O_PMK + (size_t)DEPTH * BATCH * NMEM * 4096;
constexpr size_t O_SW1 = O_SW0 + (size_t)2 * DB * 128 * 1024;
constexpr size_t O_SW2 = O_SW1 + (size_t)2 * DB * 512 * 1024;
constexpr size_t O_SCB = O_SW2 + (size_t)2 * DB * 2048 * 1024;
constexpr size_t O_SFC = O_SCB + (size_t)2 * DB * 2 * D;
constexpr size_t O_END = O_SFC + (size_t)DEPTH * DB * 2 * UP;
static_assert(O_END == 100925440ull, "output size");
constexpr size_t MiB = 1u << 20;
constexpr size_t WS_CTL = 0, CTL_ZERO_BYTES = 1 * MiB;
constexpr size_t WS_WQKV = 1 * MiB;
constexpr size_t WS_WOA = WS_WQKV + 36 * MiB;
constexpr size_t WS_WINB = WS_WOA + 4 * MiB;
constexpr size_t WS_WOB = WS_WINB + 48 * MiB;
constexpr size_t WS_WQ = WS_WOB + 16 * MiB;
constexpr size_t WS_WKV = WS_WQ + 32 * MiB;
constexpr size_t WS_WO = WS_WKV + 64 * MiB;
constexpr size_t WS_WUP = WS_WO + 32 * MiB;
constexpr size_t WS_WDN = WS_WUP + 176 * MiB;
constexpr size_t WS_Y = WS_WDN + 88 * MiB;
constexpr size_t WS_YB = WS_Y + 65 * MiB;
constexpr size_t WS_SSQ = WS_YB + 33 * MiB;
constexpr size_t WS_SSQS = WS_SSQ + 1 * MiB;
constexpr size_t WS_MEMB = WS_SSQS + 1 * MiB;
constexpr size_t WS_SSQM = WS_MEMB + 4 * MiB;
constexpr size_t WS_KVB = WS_SSQM + 1 * MiB;
constexpr size_t WS_CKV = WS_KVB + 32 * MiB;
constexpr size_t WS_BIG = WS_CKV + 64 * MiB;
constexpr size_t WS_ACT = WS_BIG + 176 * MiB;
constexpr size_t WS_QM = WS_ACT, WS_OM = WS_ACT + 33 * MiB, WS_OG = WS_ACT + 33 * MiB, WS_LSE = WS_ACT + 58 * MiB, WS_MRG = WS_ACT + 66 * MiB;
constexpr size_t WS_SMALL = WS_ACT + 99 * MiB;
constexpr size_t WS_QKVS = WS_SMALL, WS_U3S = WS_SMALL + 2 * MiB, WS_US = WS_SMALL + 4 * MiB;
constexpr size_t WS_HALO = WS_SMALL + 8 * MiB;
constexpr size_t WS_WQNT = WS_HALO + 8 * MiB;
constexpr size_t WS_MKT = WS_WQNT + 32 * MiB;
constexpr size_t WS_VWT = WS_MKT + 32 * MiB;
constexpr size_t WS_END = WS_VWT + 32 * MiB;
static_assert((size_t)MT * 5632 * 2 <= 99 * MiB && (size_t)3 * MT * 512 * 2 <= 25 * MiB && (size_t)MT * 2048 * 2 <= 33 * MiB, "ws map");
}

namespace ep {
using pg8::f32x4; using pg8::u32x4; using pg8::bf16_t; using pg8::Unit; using pg8::cvt_pk_bf16; using pg8::HALF; using pg8::BM;
__device__ __forceinline__ float row_rstd(const float* ssq, int row, int fq) {
    const f32x4* p = (const f32x4*)(ssq + (size_t)row * 32 + fq * 8);
    const f32x4 a = p[0], b = p[1];
    float s = ((a[0] + a[1]) + (a[2] + a[3])) + ((b[0] + b[1]) + (b[2] + b[3]));
    s += __shfl_xor(s, 16); s += __shfl_xor(s, 32);
    return 1.0f / sqrtf(s * (1.0f / 2048.0f) + cfg::EPS);
}
__device__ __forceinline__ void rstd_table(const float* ssq, PG8_LAS float* rt, int pm, int tid) {
    const int row = tid >> 1, hf = tid & 1; const f32x4* p = (const f32x4*)(ssq + (size_t)(pm * BM + row) * 32 + hf * 16);
    const f32x4 a = p[0], b = p[1], c = p[2], d = p[3];
    float s = (((a[0] + a[1]) + (a[2] + a[3])) + ((b[0] + b[1]) + (b[2] + b[3]))) + (((c[0] + c[1]) + (c[2] + c[3])) + ((d[0] + d[1]) + (d[2] + d[3])));
    s += __shfl_xor(s, 1);
    if (hf == 0) rt[row] = 1.0f / sqrtf(s * (1.0f / 2048.0f) + cfg::EPS);
}
__device__ __forceinline__ float rs_lookup(const float* ssq, const PG8_LAS float* rt, int pm, int rit, int fq) { (void)ssq; (void)pm; (void)fq; return rt[rit]; }
__device__ __forceinline__ u32x4 pack8(const f32x4 v0, const f32x4 v1) { u32x4 w; w.x = cvt_pk_bf16(v0[0], v0[1]); w.y = cvt_pk_bf16(v0[2], v0[3]); w.z = cvt_pk_bf16(v1[0], v1[1]); w.w = cvt_pk_bf16(v1[2], v1[3]); return w; }

struct EpiScale {
    static constexpr bool PERM = true, AFTER_DRAIN = false, ACC_INIT = false, RSTD = true;
    bf16_t* O; int ldc; const float* ssq; float scale; PG8_LAS float* rt;
    __device__ __forceinline__ void operator()(const f32x4 (&acc)[2][2][4][2], const Unit& u, int wr, int wc, int fr, int fq) const {
        const int col0 = u.pn * BM + wc * 32 + 8 * fq;
#pragma unroll
        for (int ai = 0; ai < 2; ++ai)
#pragma unroll
            for (int m = 0; m < 4; ++m) { const int rit = ai * HALF + wr * 64 + m * 16 + fr, row = u.pm * BM + rit; const float rs = rs_lookup(ssq, rt, u.pm, rit, fq) * scale;
                bf16_t* rowp = O + (size_t)row * ldc + col0;
#pragma unroll
                for (int bj = 0; bj < 2; ++bj) *(u32x4*)(rowp + bj * HALF) = pack8(acc[ai][bj][m][0] * rs, acc[ai][bj][m][1] * rs); }
    }
};
struct EpiQKV {
    static constexpr bool PERM = true, AFTER_DRAIN = false, ACC_INIT = false, RSTD = true;
    bf16_t* O; const float* ssq; float* out; int j; float qscale; PG8_LAS float* rt;
    __device__ __forceinline__ void operator()(const f32x4 (&acc)[2][2][4][2], const Unit& u, int wr, int wc, int fr, int fq) const {
        const int colt = u.pn * BM; const int g = colt / 1536, rem = colt - g * 1536, w = rem / 512, c512 = rem - w * 512;
        const float sc = (w == 0) ? qscale : 1.f;
        const int nb = u.pm >> 3, t0 = (u.pm & 7) * BM;
        const int keep = (g == 0) ? 128 : (g == 1 ? 512 : 2048);
        float* pw = out + (g == 0 ? cfg::O_PW0 : (g == 1 ? cfg::O_PW1 : cfg::O_PW2));
        const int col0 = colt + wc * 32 + 8 * fq;
#pragma unroll
        for (int ai = 0; ai < 2; ++ai)
#pragma unroll
            for (int m = 0; m < 4; ++m) { const int rit = ai * HALF + wr * 64 + m * 16 + fr, row = u.pm * BM + rit, t = t0 + rit; const float r0 = rs_lookup(ssq, rt, u.pm, rit, fq), rs = r0 * sc;
                bf16_t* rowp = O + (size_t)row * cfg::NQKV + col0;
#pragma unroll
                for (int bj = 0; bj < 2; ++bj) *(u32x4*)(rowp + bj * HALF) = pack8(acc[ai][bj][m][0] * rs, acc[ai][bj][m][1] * rs);
                if (w >= 1 && t >= 2048 - keep) {
                    float* d = pw + ((((size_t)(j * 4 + nb) * keep + (t - (2048 - keep))) * 2 + (w - 1)) * 512) + c512 + wc * 32 + 8 * fq;
#pragma unroll
                    for (int bj = 0; bj < 2; ++bj) { __builtin_nontemporal_store(acc[ai][bj][m][0] * r0, (f32x4*)(d + bj * HALF)); __builtin_nontemporal_store(acc[ai][bj][m][1] * r0, (f32x4*)(d + bj * HALF + 4)); }
                } }
    }
};
__device__ __forceinline__ float dpp_ror1(float x) { return __builtin_bit_cast(float, __builtin_amdgcn_mov_dpp(__builtin_bit_cast(int, x), 0x121, 0xF, 0xF, true)); }
__device__ __forceinline__ float dpp_ror2(float x) { return __builtin_bit_cast(float, __builtin_amdgcn_mov_dpp(__builtin_bit_cast(int, x), 0x122, 0xF, 0xF, true)); }
struct EpiUpConv {
    static constexpr bool PERM = true, AFTER_DRAIN = false, ACC_INIT = false, RSTD = true;
    bf16_t* ACT; const float* ssq; float* out; float* halog; const float* cw; int layer; PG8_LAS float* hl; PG8_LAS float* rt;
    __device__ __forceinline__ void operator()(f32x4 (&acc)[2][2][4][2], const Unit& u, int wr, int wc, int fr, int fq) const {
        asm volatile("" : "+v"(fr), "+v"(fq));
        const int q = u.pn, nb = u.pm >> 3; const int lc = wc * 32 + 8 * fq;
#pragma unroll
        for (int ai = 0; ai < 2; ++ai)
#pragma unroll
            for (int m = 0; m < 4; ++m) { const int rit = ai * HALF + wr * 64 + m * 16 + fr; const float rs = rs_lookup(ssq, rt, u.pm, rit, fq);
#pragma unroll
                for (int bj = 0; bj < 2; ++bj)
#pragma unroll
                    for (int n = 0; n < 2; ++n) acc[ai][bj][m][n] = acc[ai][bj][m][n] * rs;
                if (m == 3 && fr >= 14) {
#pragma unroll
                    for (int bj = 0; bj < 2; ++bj)
#pragma unroll
                        for (int n = 0; n < 2; ++n) *(PG8_LAS f32x4*)(hl + (((ai * 2 + wr) * 2 + (fr - 14)) * 256 + bj * HALF + lc + 4 * n)) = acc[ai][bj][m][n]; }
                if ((ai == 0 && m == 0) || (ai == 1 && m == 3)) { if (rit < 2 || rit >= 254) { const int slot = rit < 2 ? rit : rit - 252;
                    float* hg = halog + ((size_t)(u.pm * 4 + slot) * cfg::UP) + q * 256 + lc;
#pragma unroll
                    for (int bj = 0; bj < 2; ++bj)
#pragma unroll
                        for (int n = 0; n < 2; ++n) *(f32x4*)(hg + bj * HALF + 4 * n) = acc[ai][bj][m][n];
                    if (rit >= 254 && (u.pm & 7) == 7) { float* d = out + cfg::O_PFC + ((size_t)(layer * 4 + nb) * 2 + (rit - 254)) * cfg::UP + q * 128 + lc;
#pragma unroll
                        for (int n = 0; n < 2; ++n) { *(f32x4*)(d + 4 * n) = acc[ai][0][m][n]; *(f32x4*)(d + cfg::DFF + 4 * n) = acc[ai][1][m][n]; } } } }
            }
        asm volatile("s_waitcnt lgkmcnt(0)" ::: "memory"); __builtin_amdgcn_s_barrier(); asm volatile("" ::: "memory");
#pragma unroll
        for (int n = 0; n < 2; ++n) { const float* wp = cw + q * 128 + lc + 4 * n;
            const f32x4 wa0 = *(const f32x4*)wp, wa1 = *(const f32x4*)(wp + cfg::UP), wa2 = *(const f32x4*)(wp + 2 * cfg::UP);
            const f32x4 wb0 = *(const f32x4*)(wp + cfg::DFF), wb1 = *(const f32x4*)(wp + cfg::UP + cfg::DFF), wb2 = *(const f32x4*)(wp + 2 * cfg::UP + cfg::DFF);
#pragma unroll
            for (int ai = 0; ai < 2; ++ai) {
                f32x4 pa = (f32x4){0.f, 0.f, 0.f, 0.f}, pb = (f32x4){0.f, 0.f, 0.f, 0.f};
                if (ai == 1 || wr == 1) { const int sai = (wr == 1) ? ai : ai - 1, swr = (wr == 1) ? 0 : 1;
                    const PG8_LAS float* hp = hl + (((sai * 2 + swr) * 2 + (fr >= 14 ? fr - 14 : 0)) * 256 + lc + 4 * n);
                    pa = *(const PG8_LAS f32x4*)hp; pb = *(const PG8_LAS f32x4*)(hp + HALF); }
#pragma unroll
                for (int m = 0; m < 4; ++m) { const f32x4 ca = acc[ai][0][m][n], cb = acc[ai][1][m][n]; f32x4 o;
#pragma unroll
                    for (int i = 0; i < 4; ++i) {
                        const float a1 = dpp_ror1(fr == 15 ? pa[i] : ca[i]), a2 = dpp_ror2(fr >= 14 ? pa[i] : ca[i]);
                        const float b1 = dpp_ror1(fr == 15 ? pb[i] : cb[i]), b2 = dpp_ror2(fr >= 14 ? pb[i] : cb[i]);
                        const float va = wa0[i] * a2 + wa1[i] * a1 + wa2[i] * ca[i], vb = wb0[i] * b2 + wb1[i] * b1 + wb2[i] * cb[i];
                        o[i] = va * __builtin_amdgcn_rcpf(1.0f + __expf(-va)) * vb; }
                    const int row = u.pm * BM + ai * HALF + wr * 64 + m * 16 + fr;
                    typedef unsigned u32x2e __attribute__((ext_vector_type(2)));
                    u32x2e w; w.x = cvt_pk_bf16(o[0], o[1]); w.y = cvt_pk_bf16(o[2], o[3]);
                    *(u32x2e*)(ACT + (size_t)row * cfg::DFF + q * 128 + lc + 4 * n) = w;
                    pa = ca; pb = cb; }
            } }
    }
};
struct EpiKV {
    static constexpr bool PERM = true, AFTER_DRAIN = false, ACC_INIT = false, RSTD = true;
    bf16_t* O; const float* ssq; float* out; PG8_LAS float* rt;
    __device__ __forceinline__ void operator()(const f32x4 (&acc)[2][2][4][2], const Unit& u, int wr, int wc, int fr, int fq) const {
        const int layer = u.pn >> 4, col0 = (u.pn & 15) * BM + wc * 32 + 8 * fq;
#pragma unroll
        for (int ai = 0; ai < 2; ++ai)
#pragma unroll
            for (int m = 0; m < 4; ++m) { const int rit = ai * HALF + wr * 64 + m * 16 + fr, row = u.pm * BM + rit; const float rs = rs_lookup(ssq, rt, u.pm, rit, fq);
                const size_t off = ((size_t)layer * cfg::MM + row) * 4096 + col0;
#pragma unroll
                for (int bj = 0; bj < 2; ++bj) { const f32x4 v0 = acc[ai][bj][m][0] * rs, v1 = acc[ai][bj][m][1] * rs;
                    *(u32x4*)(O + off + bj * HALF) = pack8(v0, v1); __builtin_nontemporal_store(v0, (f32x4*)(out + cfg::O_PMK + off + bj * HALF)); __builtin_nontemporal_store(v1, (f32x4*)(out + cfg::O_PMK + off + bj * HALF + 4)); } }
    }
};
struct EpiResid {
    static constexpr bool PERM = true, AFTER_DRAIN = false, ACC_INIT = true, RSTD = false;
    bf16_t* YB; float* ssq;
    __device__ __forceinline__ void init(f32x4 (&acc)[2][2][4][2], const Unit& u, int wr, int wc, int fr, int fq) const {
        const int col0 = u.pn * BM + wc * 32 + 8 * fq;
        u32x4 raw[2][2][4];
#pragma unroll
        for (int ai = 0; ai < 2; ++ai)
#pragma unroll
            for (int m = 0; m < 4; ++m) { const size_t off = (size_t)(u.pm * BM + ai * HALF + wr * 64 + m * 16 + fr) * 2048 + col0;
#pragma unroll
                for (int bj = 0; bj < 2; ++bj) raw[ai][bj][m] = *(const u32x4*)(YB + off + bj * HALF); }
#pragma unroll
        for (int ai = 0; ai < 2; ++ai)
#pragma unroll
            for (int m = 0; m < 4; ++m)
#pragma unroll
                for (int bj = 0; bj < 2; ++bj) { const u32x4 yb = raw[ai][bj][m];
                    acc[ai][bj][m][0] = (f32x4){__uint_as_float(yb.x << 16), __uint_as_float(yb.x & 0xffff0000u), __uint_as_float(yb.y << 16), __uint_as_float(yb.y & 0xffff0000u)};
                    acc[ai][bj][m][1] = (f32x4){__uint_as_float(yb.z << 16), __uint_as_float(yb.z & 0xffff0000u), __uint_as_float(yb.w << 16), __uint_as_float(yb.w & 0xffff0000u)}; }
    }
    __device__ __forceinline__ void operator()(const f32x4 (&acc)[2][2][4][2], const Unit& u, int wr, int wc, int fr, int fq) const {
        const int col0 = u.pn * BM + wc * 32 + 8 * fq;
#pragma unroll
        for (int ai = 0; ai < 2; ++ai)
#pragma unroll
            for (int m = 0; m < 4; ++m) { const int row = u.pm * BM + ai * HALF + wr * 64 + m * 16 + fr; const size_t off = (size_t)row * 2048 + col0; float part = 0.f;
#pragma unroll
                for (int bj = 0; bj < 2; ++bj) { const f32x4 y0 = acc[ai][bj][m][0], y1 = acc[ai][bj][m][1];
                    *(u32x4*)(YB + off + bj * HALF) = pack8(y0, y1);
                    part += ((y0[0] * y0[0] + y0[1] * y0[1]) + (y0[2] * y0[2] + y0[3] * y0[3])) + ((y1[0] * y1[0] + y1[1] * y1[1]) + (y1[2] * y1[2] + y1[3] * y1[3])); }
                part += __shfl_xor(part, 16); part += __shfl_xor(part, 32);
                if (fq == 0) ssq[(size_t)row * 32 + u.pn * 4 + wc] = part; }
    }
};
struct PrepOrder {
    int mode, w, nw; const bf16_t* KVl; const bf16_t* Wl;
    __device__ __forceinline__ bool next(int i, Unit& u) const { const int q = w + i * nw; if (w < 0 || q >= 128) return false; u.z = q >> 3; const int jj = q & 7; u.pm = mode ? jj : 0; u.pn = mode ? 0 : jj; return true; }
    __device__ __forceinline__ void a_ready(const Unit&) const {}
    __device__ __forceinline__ void done(const Unit&) const {}
    __device__ __forceinline__ const char* abase(const pg8::Gemm&, const Unit& u) const { const int n = u.z >> 2, h = u.z & 3;
        return mode ? (const char*)(Wl + (size_t)(256 * u.pm) * 2048 + h * 512) : (const char*)(KVl + (size_t)(n * 256) * 4096 + h * 512); }
    __device__ __forceinline__ const char* bbase(const pg8::Gemm&, const Unit& u) const { const int n = u.z >> 2, h = u.z & 3;
        return mode ? (const char*)(KVl + (size_t)(n * 256) * 4096 + 2048 + h * 512) : (const char*)(Wl + (size_t)(256 * u.pn) * 2048 + h * 512); }
};
struct EpiPrep {
    static constexpr bool PERM = true, AFTER_DRAIN = false, ACC_INIT = false, RSTD = false;
    bf16_t* O; int ldc; float scale; size_t zn, zh;
    __device__ __forceinline__ void operator()(const f32x4 (&acc)[2][2][4][2], const Unit& u, int wr, int wc, int fr, int fq) const {
        bf16_t* base = O + (size_t)(u.z >> 2) * zn + (size_t)(u.z & 3) * zh; const int col0 = u.pn * BM + wc * 32 + 8 * fq;
#pragma unroll
        for (int ai = 0; ai < 2; ++ai)
#pragma unroll
            for (int m = 0; m < 4; ++m) { const int row = u.pm * BM + ai * HALF + wr * 64 + m * 16 + fr; bf16_t* rowp = base + (size_t)row * ldc + col0;
#pragma unroll
                for (int bj = 0; bj < 2; ++bj) *(u32x4*)(rowp + bj * HALF) = pack8(acc[ai][bj][m][0] * scale, acc[ai][bj][m][1] * scale); }
    }
};
struct ScoreOrder : pg8::StaticOrder {
    const bf16_t* MK;
    __device__ __forceinline__ const char* bbase(const pg8::Gemm&, const Unit& u) const { return (const char*)(MK + ((size_t)(u.pm >> 3) * 1024 + 256 * u.pn) * 2048); }
};
struct OutOrder : pg8::StaticOrder {
    const bf16_t* VW;
    __device__ __forceinline__ const char* bbase(const pg8::Gemm&, const Unit& u) const { return (const char*)(VW + ((size_t)(u.pm >> 3) * 2048 + 256 * u.pn) * 1024); }
};
struct EpiSoftmax {
    static constexpr bool PERM = true, AFTER_DRAIN = true, ACC_INIT = false, RSTD = true;
    bf16_t* P; const float* ssq; PG8_LAS float* rt;
    __device__ __forceinline__ void fused(f32x4 (&acc)[2][2][4][2], const Unit& u, int wr, int wc, int fr, int fq, PG8_LAS unsigned char* lds, int wid, int lane) const {
        PG8_LAS float* Pm = (PG8_LAS float*)lds; PG8_LAS float* Ps = (PG8_LAS float*)(lds + 4096);
        float mx[2][4];
#pragma unroll
        for (int ai = 0; ai < 2; ++ai)
#pragma unroll
            for (int m = 0; m < 4; ++m) { const int rit = ai * HALF + wr * 64 + m * 16 + fr; const float rs = rs_lookup(ssq, rt, u.pm, rit, fq); float v = -3.0e38f;
#pragma unroll
                for (int bj = 0; bj < 2; ++bj)
#pragma unroll
                    for (int n = 0; n < 2; ++n) { f32x4 s = acc[ai][bj][m][n] * rs; acc[ai][bj][m][n] = s; v = fmaxf(v, fmaxf(fmaxf(s[0], s[1]), fmaxf(s[2], s[3]))); }
                v = fmaxf(v, __shfl_xor(v, 16)); v = fmaxf(v, __shfl_xor(v, 32)); mx[ai][m] = v;
                if (fq == 0) Pm[rit * 4 + wc] = v; }
        asm volatile("s_waitcnt lgkmcnt(0)" ::: "memory"); __builtin_amdgcn_s_barrier(); asm volatile("" ::: "memory");
#pragma unroll
        for (int ai = 0; ai < 2; ++ai)
#pragma unroll
            for (int m = 0; m < 4; ++m) { const int rit = ai * HALF + wr * 64 + m * 16 + fr; const f32x4 pm4 = *(const PG8_LAS f32x4*)(Pm + rit * 4);
                const float M = fmaxf(fmaxf(pm4[0], pm4[1]), fmaxf(pm4[2], pm4[3])); float sum = 0.f;
#pragma unroll
                for (int bj = 0; bj < 2; ++bj)
#pragma unroll
                    for (int n = 0; n < 2; ++n) { f32x4 s = acc[ai][bj][m][n]; s[0] = exp2f(s[0] - M); s[1] = exp2f(s[1] - M); s[2] = exp2f(s[2] - M); s[3] = exp2f(s[3] - M); acc[ai][bj][m][n] = s; sum += (s[0] + s[1]) + (s[2] + s[3]); }
                sum += __shfl_xor(sum, 16); sum += __shfl_xor(sum, 32);
                if (fq == 0) Ps[rit * 4 + wc] = sum; }
        asm volatile("s_waitcnt lgkmcnt(0)" ::: "memory"); __builtin_amdgcn_s_barrier(); asm volatile("" ::: "memory");
        const int col0 = u.pn * BM + wc * 32 + 8 * fq;
#pragma unroll
        for (int ai = 0; ai < 2; ++ai)
#pragma unroll
            for (int m = 0; m < 4; ++m) { const int rit = ai * HALF + wr * 64 + m * 16 + fr; const f32x4 ps4 = *(const PG8_LAS f32x4*)(Ps + rit * 4);
                const float inv = 1.0f / ((ps4[0] + ps4[1]) + (ps4[2] + ps4[3])); bf16_t* rowp = P + (size_t)(u.pm * BM + rit) * 1024 + col0;
#pragma unroll
                for (int bj = 0; bj < 2; ++bj) *(u32x4*)(rowp + bj * HALF) = pack8(acc[ai][bj][m][0] * inv, acc[ai][bj][m][1] * inv); }
        (void)mx; (void)wid; (void)lane;
    }
};
}
namespace pg8 { __device__ __forceinline__ void ep_rstd_table(const float* ssq, PG8_LAS float* rt, int pm, int tid) { ep::rstd_table(ssq, rt, pm, tid); } }
#define GAS __attribute__((address_space(1)))
#define LAS __attribute__((address_space(3)))
typedef unsigned short bf16;
typedef unsigned v4u __attribute__((ext_vector_type(4)));
typedef float f32x4 __attribute__((ext_vector_type(4)));
typedef short bf16x8 __attribute__((ext_vector_type(8)));
typedef GAS unsigned gu32;
typedef GAS unsigned long long gu64;
#define RLX_AGENT __ATOMIC_RELAXED, __HIP_MEMORY_SCOPE_AGENT
#define LDS_WAIT() asm volatile("s_waitcnt lgkmcnt(0)" ::: "memory")
#define VM_WAIT() asm volatile("s_waitcnt vmcnt(0)" ::: "memory")
__device__ __forceinline__ unsigned long long rt() { return __builtin_amdgcn_s_memrealtime(); }
__device__ __forceinline__ unsigned f2bf(float f) { unsigned u = __builtin_bit_cast(unsigned, f); return (u + 0x7fffu + ((u >> 16) & 1u)) >> 16; }
__device__ __forceinline__ unsigned pk2(float lo, float hi) { return f2bf(lo) | (f2bf(hi) << 16); }

#define XB_TMO      128
#define XB_XCNT(j)  (256  + 64 * (j))
#define XB_XSUB(j)  (1280 + 64 * (j))
#define XB_XGEN(j)  (2304 + 64 * (j))
#define XB_TOP      3328
#define XB_TOPGEN   3392
#define XCD_BAR_WORDS 3456
#define XB_SPIN_CAP (1u << 18)

__device__ __forceinline__ unsigned xb_ld(unsigned* p)              { return __hip_atomic_load(p, __ATOMIC_RELAXED, __HIP_MEMORY_SCOPE_AGENT); }
__device__ __forceinline__ unsigned xb_add(unsigned* p, unsigned v) { return __hip_atomic_fetch_add(p, v, __ATOMIC_RELAXED, __HIP_MEMORY_SCOPE_AGENT); }
__device__ __forceinline__ unsigned xb_xcc_id() { return (unsigned)__builtin_amdgcn_s_getreg((3 << 11) | 20) & 0xFu; }
#define XB_SPIN(cond, bar) do { unsigned _sp = 0; while (cond) { __builtin_amdgcn_s_sleep(1); \
    if ((++_sp & 255u) == 0u) { if (xb_ld(&(bar)[XB_TMO])) break; if (_sp > XB_SPIN_CAP) { atomicAdd(&(bar)[XB_TMO], 1u); break; } } } } while (0)

struct XcdBarrier {
    unsigned* bar; unsigned x;
    volatile LAS unsigned* st;
};

__device__ __forceinline__ XcdBarrier xcd_barrier_post(unsigned* bar, volatile LAS unsigned* st) {
    XcdBarrier b; b.bar = bar; b.x = xb_xcc_id(); b.st = st;
    if (threadIdx.x == 0) (void)xb_add(&bar[XB_XCNT(b.x)], 1u);
    return b;
}
__device__ __forceinline__ void xcd_barrier_complete(unsigned* bar, unsigned x, unsigned& nloc, unsigned& nx) {
    const unsigned G = gridDim.x * gridDim.y * gridDim.z;
    unsigned sum, cnt, mine, sp = 0u;
    for (;;) {
        sum = 0u; cnt = 0u; mine = 0u;
#pragma unroll
        for (unsigned j = 0; j < 16; ++j) { const unsigned c = xb_ld(&bar[XB_XCNT(j)]); sum += c; cnt += (c > 0u) ? 1u : 0u; mine = (j == x) ? c : mine; }
        if (sum == G) break;
        __builtin_amdgcn_s_sleep(1);
        if ((++sp & 255u) == 0u) { if (xb_ld(&bar[XB_TMO])) break; if (sp > XB_SPIN_CAP) { atomicAdd(&bar[XB_TMO], 1u); break; } }
    }
    nloc = mine > 0u ? mine : 1u; nx = cnt > 0u ? cnt : 1u;
}

__device__ __forceinline__ void xcd_barrier(const XcdBarrier& b) {
    asm volatile("s_waitcnt vmcnt(0)" ::: "memory");
    __syncthreads();
    if (threadIdx.x == 0) {
        unsigned* bar = b.bar;
        __builtin_amdgcn_s_waitcnt(0);
        unsigned nloc = b.st[0], nx = b.st[1];
        if (nloc == 0u) { xcd_barrier_complete(bar, b.x, nloc, nx); b.st[0] = nloc; b.st[1] = nx; }
        const unsigned old = xb_add(&bar[XB_XSUB(b.x)], 1u);
        const unsigned gen = old / nloc;
        if (old + 1u == (gen + 1u) * nloc) {
            __builtin_amdgcn_fence(__ATOMIC_RELEASE, "agent");
            asm volatile("s_waitcnt vmcnt(0)" ::: "memory");
            const unsigned og = xb_add(&bar[XB_TOP], 1u);
            const unsigned tg = og / nx;
            if (og + 1u == (tg + 1u) * nx) xb_add(&bar[XB_TOPGEN], 1u);
            else XB_SPIN(xb_ld(&bar[XB_TOPGEN]) == tg, bar);
            __builtin_amdgcn_fence(__ATOMIC_ACQUIRE, "agent");
            xb_add(&bar[XB_XGEN(b.x)], 1u);
            asm volatile("s_waitcnt vmcnt(0)" ::: "memory");
        } else {
            XB_SPIN(xb_ld(&bar[XB_XGEN(b.x)]) == gen, bar);
            __builtin_amdgcn_fence(__ATOMIC_ACQUIRE, "agent");
            asm volatile("s_waitcnt vmcnt(0)" ::: "memory");
        }
    }
    __syncthreads();
}
#ifndef PROBE_SMODE
#define PROBE_SMODE 0
#endif
#ifndef PROBE_MASK
#define PROBE_MASK 0
#endif
struct Args { const float* in[25]; float* out; unsigned char* ws; int ph_lo, ph_hi; };
typedef const __attribute__((address_space(4))) Args* KArgs;

constexpr int NWAVES = 8, NTHREADS = 512;
constexpr int RING_BYTES = 131072;
constexpr int SCR_BYTES = 155648;
constexpr int MISC_OFF = SCR_BYTES;
constexpr int LDS_BYTES = SCR_BYTES + 256;
typedef unsigned u32x4g __attribute__((ext_vector_type(4)));
typedef unsigned u32x2g __attribute__((ext_vector_type(2)));
typedef float f32x2g __attribute__((ext_vector_type(2)));
typedef short s16x4g __attribute__((ext_vector_type(4)));

__device__ __forceinline__ unsigned cvtpk(float lo, float hi) { unsigned r; asm volatile("v_cvt_pk_bf16_f32 %0, %1, %2" : "=v"(r) : "v"(lo), "v"(hi)); return r; }
__device__ __forceinline__ float bf_lo(unsigned w) { return __uint_as_float(w << 16); }
__device__ __forceinline__ float bf_hi(unsigned w) { return __uint_as_float(w & 0xffff0000u); }
__device__ __forceinline__ float wave_sum(float v) {
#pragma unroll
    for (int o = 1; o < 64; o <<= 1) v += __shfl_xor(v, o);
    return v;
}
__device__ __forceinline__ float wave_max(float v) {
#pragma unroll
    for (int o = 1; o < 64; o <<= 1) v = fmaxf(v, __shfl_xor(v, o));
    return v;
}
__device__ __forceinline__ f32x4 mfma16(bf16x8 a, bf16x8 b, f32x4 c) { return __builtin_amdgcn_mfma_f32_16x16x32_bf16(a, b, c, 0, 0, 0); }
__device__ __forceinline__ s16x4g ldtr(const LAS unsigned char* p) { return __builtin_bit_cast(s16x4g, __builtin_amdgcn_ds_read_tr16_b64_v4i16((LAS s16x4g*)p)); }

__device__ __forceinline__ void unpack8(float (&d)[8], const u32x4g v) { d[0] = bf_lo(v.x); d[1] = bf_hi(v.x); d[2] = bf_lo(v.y); d[3] = bf_hi(v.y); d[4] = bf_lo(v.z); d[5] = bf_hi(v.z); d[6] = bf_lo(v.w); d[7] = bf_hi(v.w); }
__device__ __forceinline__ int up_perm_row(int n) { return n < cfg::DFF ? 256 * (n >> 7) + (n & 127) : 256 * ((n - cfg::DFF) >> 7) + 128 + ((n - cfg::DFF) & 127); }
template <bool UPPERM>
__device__ __forceinline__ void p0_transpose_item2(const float* W, const float* gain, int K, int N, bf16* WT, LAS float* scr, int item0, int item1, int lane) {
    const int nblk = N / 32; const int kr = lane >> 3, nc = (lane & 7) * 4, c = lane & 7;
    const bool two = item1 >= 0; const int it1 = two ? item1 : item0;
    const int k0a = 64 * (item0 / nblk), n0a = 32 * (item0 % nblk), k0b = 64 * (it1 / nblk), n0b = 32 * (it1 % nblk);
    f32x4 va[8], vb[8];
#pragma unroll
    for (int i = 0; i < 8; ++i) va[i] = __builtin_nontemporal_load((const GAS f32x4*)(W + (size_t)(k0a + kr + 8 * i) * N + n0a + nc));
#pragma unroll
    for (int i = 0; i < 8; ++i) vb[i] = __builtin_nontemporal_load((const GAS f32x4*)(W + (size_t)(k0b + kr + 8 * i) * N + n0b + nc));
    LAS float* scb = scr + 64 * 33;
#pragma unroll
    for (int i = 0; i < 8; ++i) { const float g = gain ? gain[k0a + kr + 8 * i] : 1.0f; LAS float* d = scr + (kr + 8 * i) * 33 + nc; d[0] = va[i].x * g; d[1] = va[i].y * g; d[2] = va[i].z * g; d[3] = va[i].w * g; }
#pragma unroll
    for (int i = 0; i < 8; ++i) { const float g = gain ? gain[k0b + kr + 8 * i] : 1.0f; LAS float* d = scb + (kr + 8 * i) * 33 + nc; d[0] = vb[i].x * g; d[1] = vb[i].y * g; d[2] = vb[i].z * g; d[3] = vb[i].w * g; }
    LDS_WAIT(); asm volatile("" ::: "memory");
#pragma unroll
    for (int jj = 0; jj < 4; ++jj) { const int n = (lane >> 3) + 8 * jj; const LAS float* s = scr + (8 * c) * 33 + n;
        v4u o; o.x = pk2(s[0 * 33], s[1 * 33]); o.y = pk2(s[2 * 33], s[3 * 33]); o.z = pk2(s[4 * 33], s[5 * 33]); o.w = pk2(s[6 * 33], s[7 * 33]);
        *(GAS v4u*)(WT + (size_t)((UPPERM ? up_perm_row(n0a) : n0a) + n) * K + k0a + 8 * c) = o; }
    if (two) {
#pragma unroll
        for (int jj = 0; jj < 4; ++jj) { const int n = (lane >> 3) + 8 * jj; const LAS float* s = scb + (8 * c) * 33 + n;
            v4u o; o.x = pk2(s[0 * 33], s[1 * 33]); o.y = pk2(s[2 * 33], s[3 * 33]); o.z = pk2(s[4 * 33], s[5 * 33]); o.w = pk2(s[6 * 33], s[7 * 33]);
            *(GAS v4u*)(WT + (size_t)((UPPERM ? up_perm_row(n0b) : n0b) + n) * K + k0b + 8 * c) = o; } }
    LDS_WAIT(); asm volatile("" ::: "memory");
}
__device__ __forceinline__ void p0_row(const float* xrow, float* yrow, bf16* ybrow, float* ssqrow, int nslots, int lane) {
    const GAS f32x4* xr = (const GAS f32x4*)xrow + lane;
    f32x4 v[8]; float s = 0.f;
#pragma unroll
    for (int q = 0; q < 8; ++q) { v[q] = xr[64 * q]; s += (v[q].x * v[q].x + v[q].y * v[q].y) + (v[q].z * v[q].z + v[q].w * v[q].w); }
    s = wave_sum(s);
    if (yrow) { GAS f32x4* yr = (GAS f32x4*)yrow + lane;
#pragma unroll
        for (int q = 0; q < 8; ++q) yr[64 * q] = v[q]; }
    GAS u32x2g* o8 = (GAS u32x2g*)ybrow + lane;
#pragma unroll
    for (int q = 0; q < 8; ++q) { u32x2g w; w.x = cvtpk(v[q].x, v[q].y); w.y = cvtpk(v[q].z, v[q].w); o8[64 * q] = w; }
    for (int q = lane; q < nslots; q += 64) ssqrow[q] = (q == 0) ? s : 0.f;
}

template <int type>
__device__ __forceinline__ void run_job(int layer, int plo, int phi, int widx, int nw, KArgs args, unsigned char* ws, float* out, LAS float* scr, int lane) {
    if constexpr (type <= 8) {
        int K = 2048, N = 2048; const float* W; const float* gain = nullptr; size_t wso;
        switch (type) {
            case 0: N = 4608; W = args->in[14]; gain = args->in[9] + (2 * layer) * 2048; wso = cfg::WS_WQKV; break;
            case 1: K = 512; W = args->in[15]; wso = cfg::WS_WOA; break;
            case 2: N = 6144; W = args->in[16]; gain = args->in[9] + (2 * layer + 1) * 2048; wso = cfg::WS_WINB; break;
            case 3: W = args->in[18]; wso = cfg::WS_WOB; break;
            case 4: W = args->in[19]; gain = args->in[10] + layer * 2048; wso = cfg::WS_WQ; break;
            case 5: N = 4096; W = args->in[20]; gain = args->in[11] + layer * 2048; wso = cfg::WS_WKV; break;
            case 6: W = args->in[21]; wso = cfg::WS_WO; break;
            case 7: N = 11264; W = args->in[22]; gain = args->in[12] + layer * 2048; wso = cfg::WS_WUP; break;
            default: K = 5632; W = args->in[24]; wso = cfg::WS_WDN; break;
        }
        W += (size_t)layer * K * N;
        bf16* WT = (bf16*)(ws + wso) + (size_t)layer * K * N;
        const int n = (K / 64) * (N / 32), lo = (int)((long)n * plo / 6), hi = (int)((long)n * phi / 6);
        for (int it = lo + widx; it < hi; it += 2 * nw) p0_transpose_item2<type == 7>(W, gain, K, N, WT, scr, it, (it + nw < hi) ? it + nw : -1, lane);
    } else if constexpr (type == 11) {
        const GAS f32x4* src = (const GAS f32x4*)(args->in[19] + (size_t)layer * 4194304); GAS u32x2g* dst = (GAS u32x2g*)((bf16*)(ws + cfg::WS_WQNT) + (size_t)layer * 4194304); const float* gq = args->in[10] + layer * 2048;
        const int n = 2048, lo = n * plo / 6, hi = n * phi / 6;
        for (int it = lo + widx; it < hi; it += nw) { f32x4 v[8]; const float g = gq[it];
#pragma unroll
            for (int q = 0; q < 8; ++q) v[q] = __builtin_nontemporal_load(src + (size_t)it * 512 + q * 64 + lane);
#pragma unroll
            for (int q = 0; q < 8; ++q) { u32x2g w; w.x = cvtpk(v[q].x * g, v[q].y * g); w.y = cvtpk(v[q].z * g, v[q].w * g); dst[(size_t)it * 512 + q * 64 + lane] = w; } }
    } else if constexpr (type == 9) {
        const GAS f32x4* src = (const GAS f32x4*)(args->in[8] + (size_t)layer * 8388608); GAS u32x2g* dst = (GAS u32x2g*)((bf16*)(ws + cfg::WS_CKV) + (size_t)layer * 8388608);
        const int n = 4096, lo = n * plo / 6, hi = n * phi / 6;
        for (int it = lo + widx; it < hi; it += nw) { f32x4 v[8];
#pragma unroll
            for (int q = 0; q < 8; ++q) v[q] = __builtin_nontemporal_load(src + (size_t)it * 512 + q * 64 + lane);
#pragma unroll
            for (int q = 0; q < 8; ++q) { u32x2g w; w.x = cvtpk(v[q].x, v[q].y); w.y = cvtpk(v[q].z, v[q].w); dst[(size_t)it * 512 + q * 64 + lane] = w; } }
    } else {
        const int n = 21312, lo = (int)((long)n * plo / 6), hi = (int)((long)n * phi / 6);
        for (int it = lo + widx; it < hi; it += nw) {
            int g, r = it; if (r < 960) g = 0; else if (r < 4992) { g = 1; r -= 960; } else { g = 2; r -= 4992; }
            const int W = (g == 0) ? 128 : (g == 1 ? 512 : 2048), per = (W - 8) / 2, jn = r / per, x = r - jn * per;
            const GAS f32x4* src = (const GAS f32x4*)((g == 0 ? args->in[3] : (g == 1 ? args->in[4] : args->in[5])) + ((size_t)jn * W + 8) * 1024 + (size_t)x * 2048);
            GAS f32x4* dst = (GAS f32x4*)(out + (g == 0 ? cfg::O_SW0 : (g == 1 ? cfg::O_SW1 : cfg::O_SW2)) + (size_t)jn * W * 1024 + (size_t)x * 2048);
            f32x4 v[8];
#pragma unroll
            for (int q = 0; q < 8; ++q) v[q] = __builtin_nontemporal_load(src + q * 64 + lane);
#pragma unroll
            for (int q = 0; q < 8; ++q) __builtin_nontemporal_store(v[q], dst + q * 64 + lane); }
    }
}
#define RJ(t, l, a, b) run_job<t>(l, a, b, widx, nw, args, ws, out, scr, lane)
__device__ __forceinline__ void run_slot(int slot, int widx, int nw, KArgs args, unsigned char* ws, float* out, LAS float* scr, int lane) {
    if (slot == 0) { RJ(0, 0, 0, 6); RJ(1, 0, 0, 6); RJ(4, 0, 0, 6); for (int l = 0; l < 4; ++l) RJ(5, l, 0, 6); RJ(11, 0, 0, 6); RJ(6, 0, 0, 6); RJ(7, 0, 0, 6); RJ(8, 0, 0, 6); }
    else if (slot == 1) { RJ(6, 1, 0, 6); RJ(11, 1, 0, 6); RJ(9, 0, 0, 6); RJ(2, 0, 0, 6); RJ(3, 0, 0, 6); RJ(4, 1, 0, 6); }
    else if (slot == 2) { RJ(6, 2, 0, 6); RJ(11, 2, 0, 6); RJ(7, 1, 0, 6); }
    else if (slot == 3) { RJ(6, 3, 0, 6); RJ(11, 3, 0, 6); RJ(7, 2, 0, 6); }
    else if (slot == 4) { RJ(8, 2, 0, 6); RJ(9, 2, 0, 6); RJ(2, 1, 0, 6); }
    else if (slot == 5) { RJ(7, 3, 0, 6); RJ(10, 0, 5, 6); }
    else if (slot == 6) { RJ(10, 0, 0, 3); }
    else if (slot == 7) { RJ(8, 1, 0, 6); RJ(9, 1, 0, 6); }
    else if (slot == 8) { RJ(0, 1, 0, 6); RJ(1, 1, 0, 6); RJ(4, 2, 0, 6); }
    else if (slot == 9) { RJ(3, 1, 0, 6); RJ(4, 3, 0, 6); RJ(9, 3, 0, 6); }
    else if (slot == 11) { RJ(10, 0, 3, 5); }
    else { RJ(8, 3, 0, 6); }
}
#undef RJ

template <int KS, int RT>
__device__ __forceinline__ void sg_trip(f32x4 (&acc)[RT], const bf16* bp, const bf16* ap, int K) {
    bf16x8 b[KS], a[KS][RT];
#pragma unroll
    for (int s = 0; s < KS; ++s) { b[s] = *(const GAS bf16x8*)(bp + 32 * s);
#pragma unroll
        for (int r = 0; r < RT; ++r) a[s][r] = *(const GAS bf16x8*)(ap + (size_t)r * 16 * K + 32 * s); }
#pragma unroll
    for (int s = 0; s < KS; ++s)
#pragma unroll
        for (int r = 0; r < RT; ++r) acc[r] = mfma16(b[s], a[s][r], acc[r]);
    __builtin_amdgcn_sched_group_barrier(0x020, (1 + RT) * KS, 0);
    __builtin_amdgcn_sched_group_barrier(0x008, RT * KS, 0);
}
template <class F>
__device__ __forceinline__ void sample_gemm(LAS unsigned char* lds, const bf16* A, const bf16* Bt, int N, int K, int wg, int nwg, const F& epi, int pmode = 0) {
    int tid_ = threadIdx.x; asm volatile("" : "+v"(tid_));
    const int tid = tid_, wid = __builtin_amdgcn_readfirstlane(tid >> 6), lane = tid & 63, fr = lane & 15, fq = lane >> 4;
    const int kw = K >> 3;
    LAS f32x4* red = (LAS f32x4*)lds;
    for (int task = wg; task < (N >> 3); task += nwg) { const int ct = task >> 1, half = task & 1;
        f32x4 acc[2];
#pragma unroll
        for (int r = 0; r < 2; ++r) acc[r] = (f32x4){0.f, 0.f, 0.f, 0.f};
        const bf16* bp = Bt + (size_t)(ct * 16 + fr) * K + wid * kw + 8 * fq;
        const bf16* ap = A + (size_t)(32 * half + fr) * K + wid * kw + 8 * fq;
        f32x4 ypre = (f32x4){0.f, 0.f, 0.f, 0.f};
        if constexpr (F::PRE) { if (wid < 2) ypre = epi.pre(32 * half + 16 * wid + fr, ct * 16 + 4 * fq); }
        int k = 0;
        if (kw == 704) { sg_trip<11, 2>(acc, bp, ap, K); sg_trip<11, 2>(acc, bp + 352, ap + 352, K); k = 704; }
        for (; k + 256 <= kw; k += 256) sg_trip<8, 2>(acc, bp + k, ap + k, K);
        for (; k + 64 <= kw; k += 64) sg_trip<2, 2>(acc, bp + k, ap + k, K);
#pragma unroll
        for (int r = 0; r < 2; ++r) red[(wid * 2 + r) * 64 + lane] = acc[r];
        __syncthreads();
        if (wid < 2) { f32x4 s = red[wid * 64 + lane];
#pragma unroll
            for (int w = 1; w < 8; ++w) s += red[(w * 2 + wid) * 64 + lane];
            if constexpr (F::PRE) epi(32 * half + 16 * wid + fr, ct * 16 + 4 * fq, s, lane, ypre); else epi(32 * half + 16 * wid + fr, ct * 16 + 4 * fq, s, lane); }
        __syncthreads();
    }
}
template <class F>
__device__ __forceinline__ void sample_gemm64(LAS unsigned char* lds, const bf16* A, const bf16* Bt, int N, int K, int wg, int nwg, const F& epi) {
    int tid_ = threadIdx.x; asm volatile("" : "+v"(tid_));
    const int tid = tid_, wid = __builtin_amdgcn_readfirstlane(tid >> 6), lane = tid & 63, fr = lane & 15, fq = lane >> 4;
    const int kw = K >> 3;
    LAS f32x4* red = (LAS f32x4*)lds;
    for (int ct = (wg >= 0) ? wg : (N >> 6); ct < (N >> 6); ct += nwg) {
        f32x4 acc[4][4];
#pragma unroll
        for (int c = 0; c < 4; ++c)
#pragma unroll
            for (int r = 0; r < 4; ++r) acc[c][r] = (f32x4){0.f, 0.f, 0.f, 0.f};
        const bf16* bp = Bt + (size_t)(ct * 64 + fr) * K + wid * kw + 8 * fq;
        const bf16* ap = A + (size_t)fr * K + wid * kw + 8 * fq;
        for (int k = 0; k < kw; k += 64) {
            bf16x8 b[2][4], a[2][4];
#pragma unroll
            for (int s = 0; s < 2; ++s)
#pragma unroll
                for (int c = 0; c < 4; ++c) { b[s][c] = *(const GAS bf16x8*)(bp + (size_t)c * 16 * K + k + 32 * s); a[s][c] = *(const GAS bf16x8*)(ap + (size_t)c * 16 * K + k + 32 * s); }
#pragma unroll
            for (int s = 0; s < 2; ++s)
#pragma unroll
                for (int c = 0; c < 4; ++c)
#pragma unroll
                    for (int r = 0; r < 4; ++r) acc[c][r] = mfma16(b[s][c], a[s][r], acc[c][r]);
            __builtin_amdgcn_sched_group_barrier(0x020, 16, 0);
            __builtin_amdgcn_sched_group_barrier(0x008, 32, 0);
        }
#pragma unroll
        for (int c = 0; c < 4; ++c)
#pragma unroll
            for (int r = 0; r < 4; ++r) red[(wid * 16 + c * 4 + r) * 64 + lane] = acc[c][r];
        __syncthreads();
#pragma unroll
        for (int q = 0; q < 2; ++q) { const int tile = wid * 2 + q, c = tile >> 2, r = tile & 3; f32x4 s = red[tile * 64 + lane];
#pragma unroll
            for (int w = 1; w < 8; ++w) s += red[(w * 16 + tile) * 64 + lane];
            epi(16 * r + fr, ct * 64 + c * 16 + 4 * fq, s, lane); }
        __syncthreads();
    }
}

__device__ __forceinline__ void sample_up_conv(LAS unsigned char* lds, const bf16* A, const bf16* Wt, int wg, int nwg, const LAS float* rs, const float* cw, const float* st, float* sfc, bf16* act) {
    int tid_ = threadIdx.x; asm volatile("" : "+v"(tid_));
    const int tid = tid_, wid = __builtin_amdgcn_readfirstlane(tid >> 6), lane = tid & 63, fr = lane & 15, fq = lane >> 4;
    const int kw = 256;
    LAS f32x4* red = (LAS f32x4*)lds;
    for (int ct = (wg >= 0) ? wg : 176; ct < 176; ct += nwg) {
        const int ch0 = 32 * ct, rowa = 256 * (ch0 >> 7) + (ch0 & 127);
        f32x4 acc[4][4];
#pragma unroll
        for (int c = 0; c < 4; ++c)
#pragma unroll
            for (int r = 0; r < 4; ++r) acc[c][r] = (f32x4){0.f, 0.f, 0.f, 0.f};
        const bf16* bp = Wt + (size_t)(rowa + fr) * 2048 + wid * kw + 8 * fq;
        const bf16* ap = A + (size_t)fr * 2048 + wid * kw + 8 * fq;
        for (int k = 0; k < kw; k += 64) {
            bf16x8 b[2][4], a[2][4];
#pragma unroll
            for (int s2 = 0; s2 < 2; ++s2)
#pragma unroll
                for (int c = 0; c < 4; ++c) { b[s2][c] = *(const GAS bf16x8*)(bp + (size_t)((c & 1) * 16 + (c >> 1) * 128) * 2048 + k + 32 * s2); a[s2][c] = *(const GAS bf16x8*)(ap + (size_t)c * 16 * 2048 + k + 32 * s2); }
#pragma unroll
            for (int s2 = 0; s2 < 2; ++s2)
#pragma unroll
                for (int c = 0; c < 4; ++c)
#pragma unroll
                    for (int r = 0; r < 4; ++r) acc[c][r] = mfma16(b[s2][c], a[s2][r], acc[c][r]);
            __builtin_amdgcn_sched_group_barrier(0x020, 16, 0);
            __builtin_amdgcn_sched_group_barrier(0x008, 32, 0);
        }
#pragma unroll
        for (int c = 0; c < 4; ++c)
#pragma unroll
            for (int r = 0; r < 4; ++r) red[(wid * 16 + c * 4 + r) * 64 + lane] = acc[c][r];
        __syncthreads();
        { const int r = wid & 3, cp = wid >> 2, ta = cp * 4 + r, tb = (2 + cp) * 4 + r;
          f32x4 va = red[ta * 64 + lane], vb = red[tb * 64 + lane];
#pragma unroll
          for (int w = 1; w < 8; ++w) { va += red[(w * 16 + ta) * 64 + lane]; vb += red[(w * 16 + tb) * 64 + lane]; }
          const int row = 16 * r + fr, n = row >> 3, t = row & 7, ch = ch0 + 16 * cp + 4 * fq;
          const float rsv = rs[row]; va = va * rsv; vb = vb * rsv;
          if (t >= 6) { float* d = sfc + ((size_t)n * 2 + (t - 6)) * cfg::UP + ch; *(GAS f32x4*)d = va; *(GAS f32x4*)(d + cfg::DFF) = vb; }
          const float* sp = st + ((size_t)n * 2) * cfg::UP + ch;
          const f32x4 sa0 = *(const GAS f32x4*)sp, sa1 = *(const GAS f32x4*)(sp + cfg::UP), sb0 = *(const GAS f32x4*)(sp + cfg::DFF), sb1 = *(const GAS f32x4*)(sp + cfg::UP + cfg::DFF);
          const f32x4 wa0 = *(const GAS f32x4*)(cw + ch), wa1 = *(const GAS f32x4*)(cw + cfg::UP + ch), wa2 = *(const GAS f32x4*)(cw + 2 * cfg::UP + ch);
          const f32x4 wb0 = *(const GAS f32x4*)(cw + cfg::DFF + ch), wb1 = *(const GAS f32x4*)(cw + cfg::UP + cfg::DFF + ch), wb2 = *(const GAS f32x4*)(cw + 2 * cfg::UP + cfg::DFF + ch);
          f32x4 a1, a2, b1, b2;
#pragma unroll
          for (int i = 0; i < 4; ++i) { a1[i] = __shfl_up(va[i], 1, 16); a2[i] = __shfl_up(va[i], 2, 16); b1[i] = __shfl_up(vb[i], 1, 16); b2[i] = __shfl_up(vb[i], 2, 16); }
          if (t == 0) { a1 = sa1; a2 = sa0; b1 = sb1; b2 = sb0; } else if (t == 1) { a2 = sa1; b2 = sb1; }
          const f32x4 ca = wa0 * a2 + wa1 * a1 + wa2 * va, cb = wb0 * b2 + wb1 * b1 + wb2 * vb;
          f32x4 o; o[0] = ca[0] / (1.0f + __expf(-ca[0])) * cb[0]; o[1] = ca[1] / (1.0f + __expf(-ca[1])) * cb[1]; o[2] = ca[2] / (1.0f + __expf(-ca[2])) * cb[2]; o[3] = ca[3] / (1.0f + __expf(-ca[3])) * cb[3];
          u32x2g w2; w2.x = cvtpk(o[0], o[1]); w2.y = cvtpk(o[2], o[3]); *(GAS u32x2g*)(act + (size_t)row * cfg::DFF + ch) = w2; }
        __syncthreads();
    }
}
__device__ __forceinline__ void sample_rstd_table(LAS float* tab, const float* ssqs) {
    int tid_ = threadIdx.x; asm volatile("" : "+v"(tid_));
    const int tid = tid_, row = tid >> 3, part = tid & 7;
    const GAS f32x4* p = (const GAS f32x4*)(ssqs + (size_t)row * 128 + part * 16);
    float s = 0.f;
#pragma unroll
    for (int q = 0; q < 4; ++q) { const f32x4 a = p[q]; s += (a.x + a.y) + (a.z + a.w); }
    s += __shfl_xor(s, 1); s += __shfl_xor(s, 2); s += __shfl_xor(s, 4);
    if (part == 0) tab[row] = 1.0f / sqrtf(s * (1.0f / 2048.0f) + cfg::EPS);
    __syncthreads();
}
constexpr int DA_KSTR = 272, DA_VSTR = 288, DA_VOFF = 256 * DA_KSTR;
static_assert(DA_VOFF + 256 * DA_VSTR <= SCR_BYTES, "dilated attention LDS");
struct DaUnit { int d, r, b, cq; size_t rowbase; int g, h; };
__device__ __forceinline__ DaUnit da_decode(int u) {
    DaUnit x; const int n = u / 192, g = (u / 64) % 3, h = (u >> 4) & 3, xx = u & 15;
    const int lg = (g == 0) ? 0 : (g == 1 ? 2 : 4); x.d = 1 << lg; x.r = xx & (x.d - 1); x.b = xx >> lg; x.cq = g * 1536 + h * 128; x.rowbase = (size_t)n * 2048; x.g = g; x.h = h; return x;
}
__device__ __forceinline__ void da_load(const bf16* QKV, const DaUnit& x, int tid, u32x4g (&kr)[8], u32x4g (&vr)[8]) {
#pragma unroll
    for (int x8 = 0; x8 < 8; ++x8) { const int c = tid + 512 * x8, row = c >> 4, ch = c & 15, kk = 128 * (x.b - 1) + row;
        kr[x8] = (u32x4g){0u, 0u, 0u, 0u}; vr[x8] = (u32x4g){0u, 0u, 0u, 0u};
        if (kk >= 0) { const bf16* src = QKV + (x.rowbase + (size_t)kk * x.d + x.r) * cfg::NQKV + x.cq + ch * 8; kr[x8] = *(const GAS u32x4g*)(src + 512); vr[x8] = *(const GAS u32x4g*)(src + 1024); } }
}
__device__ __forceinline__ void dattn_phase(LAS unsigned char* lds, const bf16* QKV, bf16* OG, float* LSE, int wg, int nwg) {
    int tid_ = threadIdx.x; asm volatile("" : "+v"(tid_));
    const int tid = tid_, wid = __builtin_amdgcn_readfirstlane(tid >> 6), lane = tid & 63, fr = lane & 15, fq = lane >> 4;
    LAS unsigned char* Ks = lds; LAS unsigned char* Vs = lds + DA_VOFF;
    if (wg >= 768) return;
    u32x4g kr[8], vr[8];
    DaUnit x = da_decode(wg);
    da_load(QKV, x, tid, kr, vr);
    for (int u = wg; u < 768; u += nwg) {
#pragma unroll
        for (int x8 = 0; x8 < 8; ++x8) { const int c = tid + 512 * x8, row = c >> 4, ch = c & 15;
            *(LAS u32x4g*)(Ks + row * DA_KSTR + ch * 16) = kr[x8]; *(LAS u32x4g*)(Vs + row * DA_VSTR + ch * 16) = vr[x8]; }
        const int b = x.b, d = x.d, r = x.r, cq = x.cq, g = x.g, h = x.h; const size_t rowbase = x.rowbase;
        const int iq = 128 * b + 16 * wid + fr;
        const size_t qrow = rowbase + (size_t)iq * d + r;
        bf16x8 qa[4];
#pragma unroll
        for (int ks = 0; ks < 4; ++ks) qa[ks] = *(const GAS bf16x8*)(QKV + qrow * cfg::NQKV + cq + 32 * ks + 8 * fq);
        __syncthreads();
        if (u + nwg < 768) { x = da_decode(u + nwg); da_load(QKV, x, tid, kr, vr); }
        f32x4 st[16];
#pragma unroll
        for (int kt = 0; kt < 16; ++kt) { st[kt] = (f32x4){0.f, 0.f, 0.f, 0.f};
#pragma unroll
            for (int ks = 0; ks < 4; ++ks) { const bf16x8 kf = *(const LAS bf16x8*)(Ks + (16 * kt + fr) * DA_KSTR + (32 * ks + 8 * fq) * 2); st[kt] = mfma16(kf, qa[ks], st[kt]); } }
        float mx = -1e30f;
#pragma unroll
        for (int kt = 0; kt < 16; ++kt)
#pragma unroll
            for (int i = 0; i < 4; ++i) { const int ik = 128 * (b - 1) + 16 * kt + 4 * fq + i, dist = iq - ik; const bool valid = (dist >= 0) && (dist <= 128) && (ik >= 0);
                const float s = valid ? st[kt][i] : -1e30f; st[kt][i] = s; mx = fmaxf(mx, s); }
        mx = fmaxf(mx, __shfl_xor(mx, 16)); mx = fmaxf(mx, __shfl_xor(mx, 32));
        float sum = 0.f;
#pragma unroll
        for (int kt = 0; kt < 16; ++kt)
#pragma unroll
            for (int i = 0; i < 4; ++i) { const float p = exp2f(st[kt][i] - mx); st[kt][i] = p; sum += p; }
        sum += __shfl_xor(sum, 16); sum += __shfl_xor(sum, 32);
        bf16x8 pb[8];
#pragma unroll
        for (int s2 = 0; s2 < 8; ++s2) { u32x4g w; w.x = cvtpk(st[2 * s2][0], st[2 * s2][1]); w.y = cvtpk(st[2 * s2][2], st[2 * s2][3]); w.z = cvtpk(st[2 * s2 + 1][0], st[2 * s2 + 1][1]); w.w = cvtpk(st[2 * s2 + 1][2], st[2 * s2 + 1][3]);
            pb[s2] = __builtin_bit_cast(bf16x8, w); }
        f32x4 ot[8];
#pragma unroll
        for (int c = 0; c < 8; ++c) ot[c] = (f32x4){0.f, 0.f, 0.f, 0.f};
        const int q4 = fr >> 2, p4 = fr & 3;
        const LAS unsigned char* vb = Vs + (4 * fq + q4) * DA_VSTR + p4 * 8;
#pragma unroll
        for (int s2 = 0; s2 < 8; ++s2)
#pragma unroll
            for (int c = 0; c < 8; ++c) { const s16x4g v0 = ldtr(vb + (32 * s2) * DA_VSTR + c * 32), v1 = ldtr(vb + (32 * s2 + 16) * DA_VSTR + c * 32);
                const bf16x8 vf = (bf16x8){v0[0], v0[1], v0[2], v0[3], v1[0], v1[1], v1[2], v1[3]}; ot[c] = mfma16(vf, pb[s2], ot[c]); }
        const float inv = 1.0f / sum;
        bf16* orow = OG + ((size_t)g * cfg::MT + qrow) * 512 + h * 128 + 4 * fq;
#pragma unroll
        for (int c = 0; c < 8; ++c) { u32x2g w; w.x = cvtpk(ot[c][0] * inv, ot[c][1] * inv); w.y = cvtpk(ot[c][2] * inv, ot[c][3] * inv); *(GAS u32x2g*)(orow + 16 * c) = w; }
        if (fq == 0) LSE[((size_t)g * cfg::MT + qrow) * 4 + h] = (mx + log2f(sum)) * cfg::LN2;
        __syncthreads();
    }
}

__device__ __forceinline__ void dattn_sample(LAS float* qs  , const float* QKVS, const float* cache0, const float* cache1, const float* cache2, int j, bf16* OG, float* LSE, int task, int lane) {
    const int n = task / 96, t = (task / 12) & 7, g = (task % 12) >> 2, h = task & 3;
    const int d = (g == 0) ? 1 : (g == 1 ? 4 : 16), W = (g == 0) ? 128 : (g == 1 ? 512 : 2048);
    const float* cache = ((g == 0) ? cache0 : (g == 1 ? cache1 : cache2)) + (size_t)(j * 8 + n) * W * 1024 + h * 128;
    const float* newb = QKVS + (size_t)(n * 8) * cfg::NQKV + g * 1536 + h * 128;
    const float* qp = newb + (size_t)t * cfg::NQKV;
    { const f32x2g qv = *(const GAS f32x2g*)(qp + 2 * lane); qs[2 * lane] = qv.x; qs[2 * lane + 1] = qv.y; }
    LDS_WAIT(); asm volatile("" ::: "memory");
    float sc[3];
#pragma unroll
    for (int rnd = 0; rnd < 3; ++rnd) { const int m = lane + 64 * rnd; float acc = -1e30f;
        if (m <= 128) { const int idx = W + t - d * m; const float* kp = (idx < W) ? (cache + (size_t)idx * 1024) : (newb + (size_t)(idx - W) * cfg::NQKV + 512);
            float a = 0.f;
#pragma unroll 8
            for (int e4 = 0; e4 < 32; ++e4) { const f32x4 kv = *(const GAS f32x4*)(kp + 4 * e4); const f32x4 qv = *(const LAS f32x4*)(qs + 4 * e4); a += (kv.x * qv.x + kv.y * qv.y) + (kv.z * qv.z + kv.w * qv.w); }
            acc = a * 0.08838834764831845f; }
        sc[rnd] = acc; }
    const float mx = wave_max(fmaxf(fmaxf(sc[0], sc[1]), sc[2]));
    float p0 = __expf(sc[0] - mx), p1 = __expf(sc[1] - mx), p2 = (lane == 0) ? __expf(sc[2] - mx) : 0.f;
    const float sum = wave_sum(p0 + p1 + p2);
    float o0 = 0.f, o1 = 0.f;
    for (int m0 = 0; m0 < 128; m0 += 8) {
        f32x2g vv[8]; float pv[8];
#pragma unroll
        for (int q = 0; q < 8; ++q) { const int m = m0 + q, idx = W + t - d * m; const float* vp = (idx < W) ? (cache + (size_t)idx * 1024 + 512) : (newb + (size_t)(idx - W) * cfg::NQKV + 1024);
            vv[q] = *(const GAS f32x2g*)(vp + 2 * lane); pv[q] = (m0 < 64) ? __shfl(p0, m) : __shfl(p1, m - 64); }
#pragma unroll
        for (int q = 0; q < 8; ++q) { o0 += pv[q] * vv[q].x; o1 += pv[q] * vv[q].y; } }
    { const int idx = W + t - d * 128; const float* vp = cache + (size_t)idx * 1024 + 512;
      const float pv = __shfl(p2, 0); const f32x2g vv = *(const GAS f32x2g*)(vp + 2 * lane); o0 += pv * vv.x; o1 += pv * vv.y; }
    const float inv = 1.0f / sum; const size_t row = (size_t)cfg::MP + n * 8 + t;
    *(GAS unsigned*)(OG + ((size_t)g * cfg::MT + row) * 512 + h * 128 + 2 * lane) = cvtpk(o0 * inv, o1 * inv);
    if (lane == 0) LSE[((size_t)g * cfg::MT + row) * 4 + h] = mx + __logf(sum);
    LDS_WAIT(); asm volatile("" ::: "memory");
}


__device__ __forceinline__ void dattn_sample_half(LAS float* qs, LAS float* xch, const float* QKVS, const float* cache0, const float* cache1, const float* cache2, int j, int task, int half, int lane) {
    const int n = task / 96, t = (task / 12) & 7, g = (task % 12) >> 2, h = task & 3;
    const int d = (g == 0) ? 1 : (g == 1 ? 4 : 16), W = (g == 0) ? 128 : (g == 1 ? 512 : 2048);
    const float* cache = ((g == 0) ? cache0 : (g == 1 ? cache1 : cache2)) + (size_t)(j * 8 + n) * W * 1024 + h * 128;
    const float* newb = QKVS + (size_t)(n * 8) * cfg::NQKV + g * 1536 + h * 128;
    const float* qp = newb + (size_t)t * cfg::NQKV;
    const f32x2g qv2 = *(const GAS f32x2g*)(qp + 2 * lane);
    { qs[2 * lane] = qv2.x; qs[2 * lane + 1] = qv2.y; }
    f32x2g k128 = (f32x2g){0.f, 0.f};
    if (half == 0) k128 = *(const GAS f32x2g*)(cache + (size_t)t * 1024 + 2 * lane);
    LDS_WAIT(); asm volatile("" ::: "memory");
    float s0;
    { const int m = lane + 64 * half, idx = W + t - d * m; const float* kp = (idx < W) ? (cache + (size_t)idx * 1024) : (newb + (size_t)(idx - W) * cfg::NQKV + 512);
      float a = 0.f;
#pragma unroll 16
      for (int e4 = 0; e4 < 32; ++e4) { const f32x4 kv = *(const GAS f32x4*)(kp + 4 * e4); const f32x4 qv = *(const LAS f32x4*)(qs + 4 * e4); a += (kv.x * qv.x + kv.y * qv.y) + (kv.z * qv.z + kv.w * qv.w); }
      s0 = a * 0.08838834764831845f; }
    const float s128 = (half == 0) ? wave_sum(k128.x * qv2.x + k128.y * qv2.y) * 0.08838834764831845f : -1e30f;
    const float mx = fmaxf(wave_max(s0), s128);
    const float p0 = __expf(s0 - mx), p128 = (half == 0) ? __expf(s128 - mx) : 0.f;
    const float sum = wave_sum(p0) + p128;
    float o0 = 0.f, o1 = 0.f;
#pragma unroll 1
    for (int m0 = 0; m0 < 64; m0 += 16) {
        f32x2g vv[16]; float pv[16];
#pragma unroll
        for (int q = 0; q < 16; ++q) { const int m = 64 * half + m0 + q, idx = W + t - d * m; const float* vp = (idx < W) ? (cache + (size_t)idx * 1024 + 512) : (newb + (size_t)(idx - W) * cfg::NQKV + 1024);
            vv[q] = *(const GAS f32x2g*)(vp + 2 * lane); pv[q] = __shfl(p0, m0 + q); }
#pragma unroll
        for (int q = 0; q < 16; ++q) { o0 += pv[q] * vv[q].x; o1 += pv[q] * vv[q].y; } }
    if (half == 0) { const f32x2g vv = *(const GAS f32x2g*)(cache + (size_t)t * 1024 + 512 + 2 * lane); o0 += p128 * vv.x; o1 += p128 * vv.y; }
    LAS float* x = xch + half * 130;
    x[2 * lane] = o0; x[2 * lane + 1] = o1; if (lane == 0) { x[128] = mx; x[129] = sum; }
}
__device__ __forceinline__ void dattn_sample_merge(const LAS float* xch, bf16* OG, float* LSE, int task, int lane) {
    const int n = task / 96, t = (task / 12) & 7, g = (task % 12) >> 2, h = task & 3;
    const float m0 = xch[128], s0 = xch[129], m1 = xch[130 + 128], s1 = xch[130 + 129];
    const float M = fmaxf(m0, m1), e0 = __expf(m0 - M), e1 = __expf(m1 - M), sum = s0 * e0 + s1 * e1, inv = 1.0f / sum;
    const float o0 = (xch[2 * lane] * e0 + xch[130 + 2 * lane] * e1) * inv, o1 = (xch[2 * lane + 1] * e0 + xch[130 + 2 * lane + 1] * e1) * inv;
    const size_t row = (size_t)cfg::MP + n * 8 + t;
    *(GAS unsigned*)(OG + ((size_t)g * cfg::MT + row) * 512 + h * 128 + 2 * lane) = cvtpk(o0, o1);
    if (lane == 0) LSE[((size_t)g * cfg::MT + row) * 4 + h] = M + __logf(sum);
}
constexpr int MA_KSTR = 1040, MA_VSTR = 544, MA_BUF = 64 * MA_KSTR;
static_assert(2 * MA_BUF <= SCR_BYTES && 64 * MA_VSTR <= MA_BUF, "memory attention LDS");
template <bool FROMP  >
__device__ __forceinline__ void memattn_unit(LAS unsigned char* lds, const bf16* Qb  , int row0  , bool sample  , const bf16* kbase  , const bf16* vbase, bf16* Ob  ) {
    int tid_ = threadIdx.x; asm volatile("" : "+v"(tid_));
    const int tid = tid_, lane = tid & 63, fr = lane & 15, fq = lane >> 4, wid = __builtin_amdgcn_readfirstlane(tid >> 6);
    const int qrow_i = sample ? row0 + (fr & 7) : row0 + wid * 16 + fr; const bool wr_ok = sample ? (wid == 0 && fr < 8) : true;
    bf16x8 qa[16];
    f32x4 st[16]; bf16x8 pb[8]; f32x4 ot[16]; float inv = 1.f;
    if constexpr (FROMP) {
#pragma unroll
        for (int s2 = 0; s2 < 8; ++s2) { const GAS char* pp = (const GAS char*)Qb + (unsigned)(qrow_i * 2048 + (32 * s2 + 4 * fq) * 2); const u32x2g lo = *(const GAS u32x2g*)pp, hi = *(const GAS u32x2g*)(pp + 32);
            pb[s2] = __builtin_bit_cast(bf16x8, (u32x4g){lo.x, lo.y, hi.x, hi.y}); }
    } else {
#pragma unroll
        for (int ks = 0; ks < 16; ++ks) qa[ks] = *(const GAS bf16x8*)((const GAS char*)Qb + (unsigned)(qrow_i * 4096 + ks * 64 + fq * 16));
#pragma unroll
        for (int kt = 0; kt < 16; ++kt) st[kt] = (f32x4){0.f, 0.f, 0.f, 0.f};
    }
    u32x4g pr[8];
    const unsigned vk = (unsigned)((tid >> 6) * 8192 + (tid & 63) * 16), vv = (unsigned)((tid >> 5) * 8192 + (tid & 31) * 16);
    const unsigned lk = (unsigned)((tid >> 6) * MA_KSTR + (tid & 63) * 16), lv = (unsigned)((tid >> 5) * MA_VSTR + (tid & 31) * 16);
#define MA_LOAD(c) do { if ((c) < 4) { const GAS char* src_ = (const GAS char*)(kbase + (size_t)((c) * 64) * 4096); _Pragma("unroll") for (int x8 = 0; x8 < 8; ++x8) pr[x8] = *(const GAS u32x4g*)(src_ + x8 * 65536 + vk); } \
        else { const GAS char* src_ = (const GAS char*)(vbase + (size_t)((((c) - 4) & 3) * 64) * 4096 + (((c) - 4) >> 2) * 256); _Pragma("unroll") for (int x8 = 0; x8 < 4; ++x8) pr[x8] = *(const GAS u32x4g*)(src_ + x8 * 131072 + vv); } } while (0)
#define MA_STORE(c) do { LAS unsigned char* dst_ = lds + ((c) & 1) * MA_BUF; if ((c) < 4) { _Pragma("unroll") for (int x8 = 0; x8 < 8; ++x8) *(LAS u32x4g*)(dst_ + x8 * 8 * MA_KSTR + lk) = pr[x8]; } \
        else { _Pragma("unroll") for (int x8 = 0; x8 < 4; ++x8) *(LAS u32x4g*)(dst_ + x8 * 16 * MA_VSTR + lv) = pr[x8]; } } while (0)
    constexpr int C0 = FROMP ? 4 : 0;
    MA_LOAD(C0);
    const int q4 = fr >> 2, p4 = fr & 3;
#pragma unroll
    for (int c = C0; c < 12; ++c) {
        MA_STORE(c);
        __syncthreads();
        if (c < 11) MA_LOAD(c + 1);
        const LAS unsigned char* buf = lds + (c & 1) * MA_BUF;
        if (c < 4) {
#pragma unroll
            for (int k4 = 0; k4 < 4; ++k4)
#pragma unroll
                for (int ks = 0; ks < 16; ++ks) { const bf16x8 kf = *(const LAS bf16x8*)(buf + (16 * k4 + fr) * MA_KSTR + (32 * ks + 8 * fq) * 2); st[4 * c + k4] = mfma16(kf, qa[ks], st[4 * c + k4]); }
            if (c == 3) {
                float mx = -1e30f;
#pragma unroll
                for (int kt = 0; kt < 16; ++kt) mx = fmaxf(mx, fmaxf(fmaxf(st[kt][0], st[kt][1]), fmaxf(st[kt][2], st[kt][3])));
                mx = fmaxf(mx, __shfl_xor(mx, 16)); mx = fmaxf(mx, __shfl_xor(mx, 32));
                float s = 0.f;
#pragma unroll
                for (int kt = 0; kt < 16; ++kt)
#pragma unroll
                    for (int i = 0; i < 4; ++i) { const float p = exp2f(st[kt][i] - mx); st[kt][i] = p; s += p; }
                s += __shfl_xor(s, 16); s += __shfl_xor(s, 32); inv = 1.0f / s;
#pragma unroll
                for (int s2 = 0; s2 < 8; ++s2) { u32x4g w; w.x = cvtpk(st[2 * s2][0], st[2 * s2][1]); w.y = cvtpk(st[2 * s2][2], st[2 * s2][3]); w.z = cvtpk(st[2 * s2 + 1][0], st[2 * s2 + 1][1]); w.w = cvtpk(st[2 * s2 + 1][2], st[2 * s2 + 1][3]);
                    pb[s2] = __builtin_bit_cast(bf16x8, w); }
            }
        } else {
            const int kc = (c - 4) & 3, eh = (c - 4) >> 2;
            const LAS unsigned char* vb = buf + (4 * fq + q4) * MA_VSTR + p4 * 8;
#pragma unroll
            for (int s2 = 0; s2 < 2; ++s2)
#pragma unroll
                for (int ec = 0; ec < 16; ++ec) { const s16x4g v0 = ldtr(vb + (32 * s2) * MA_VSTR + ec * 32), v1 = ldtr(vb + (32 * s2 + 16) * MA_VSTR + ec * 32);
                    const bf16x8 vf = (bf16x8){v0[0], v0[1], v0[2], v0[3], v1[0], v1[1], v1[2], v1[3]};
                    ot[ec] = mfma16(vf, pb[2 * kc + s2], (kc == 0 && s2 == 0) ? (f32x4){0.f, 0.f, 0.f, 0.f} : ot[ec]); }
            if (kc == 3) {
                if (wr_ok) { GAS char* orow = (GAS char*)Ob + (unsigned)(qrow_i * 4096 + eh * 512 + fq * 8);
#pragma unroll
                    for (int ec = 0; ec < 16; ++ec) { u32x2g w; w.x = cvtpk(ot[ec][0] * inv, ot[ec][1] * inv); w.y = cvtpk(ot[ec][2] * inv, ot[ec][3] * inv); *(GAS u32x2g*)(orow + 32 * ec) = w; } }
            }
        }
    }
#undef MA_LOAD
#undef MA_STORE
    __syncthreads();
}
struct SEpiF32 {
    static constexpr bool PRE = false;
    float* dst; int ld; const LAS float* rs; float* out; int mode; int idx;
    __device__ __forceinline__ void operator()(int row, int col, f32x4 v, int lane) const {
        v = v * rs[row];
        const int n = row >> 3, t = row & 7;
        if (mode == 2) { const int qq = col >> 8, w8 = col & 255; col = (w8 < 128) ? 128 * qq + w8 : cfg::DFF + 128 * qq + (w8 - 128); }
        *(GAS f32x4*)(dst + (size_t)row * ld + col) = v;
        if (mode == 1) { const int g = col / 1536, rem = col - g * 1536, w = rem >> 9, c512 = rem & 511;
            if (w >= 1) { const int W = (g == 0) ? 128 : (g == 1 ? 512 : 2048); float* sw = out + (g == 0 ? cfg::O_SW0 : (g == 1 ? cfg::O_SW1 : cfg::O_SW2));
                *(GAS f32x4*)(sw + ((((size_t)(idx * 8 + n) * W + (W - 8 + t)) * 2 + (w - 1)) * 512) + c512) = v; } }
        else if (mode == 2) { if (t >= 6) *(GAS f32x4*)(out + cfg::O_SFC + ((size_t)(idx * 8 + n) * 2 + (t - 6)) * cfg::UP + col) = v; }
    }
};
struct SEpiBf16 {
    static constexpr bool PRE = false;
    bf16* dst; int ld; const LAS float* rs; float scale;
    __device__ __forceinline__ void operator()(int row, int col, f32x4 v, int lane) const {
        v = v * (rs[row] * scale); u32x2g w; w.x = cvtpk(v[0], v[1]); w.y = cvtpk(v[2], v[3]); *(GAS u32x2g*)(dst + (size_t)row * ld + col) = w;
    }
};
struct SEpiResid {
    static constexpr bool PRE = true;
    float* Y; bf16* YB; float* ssqs;
    __device__ __forceinline__ f32x4 pre(int row, int col) const { return *(const GAS f32x4*)(Y + (size_t)row * 2048 + col); }
    __device__ __forceinline__ void operator()(int row, int col, f32x4 v, int lane, f32x4 y) const {
        y += v;
        *(GAS f32x4*)(Y + (size_t)row * 2048 + col) = y; u32x2g w; w.x = cvtpk(y[0], y[1]); w.y = cvtpk(y[2], y[3]); *(GAS u32x2g*)(YB + (size_t)row * 2048 + col) = w;
        float p = (y[0] * y[0] + y[1] * y[1]) + (y[2] * y[2] + y[3] * y[3]); p += __shfl_xor(p, 16); p += __shfl_xor(p, 32);
        if ((lane >> 4) == 0) ssqs[(size_t)row * 128 + (col >> 4)] = p;
    }
};

#ifndef MK_CUTS_ON
#define MK_CUTS_ON 0
#endif
__global__ void __launch_bounds__(NTHREADS, 2) mk_fwd(Args args) {
    extern __shared__ __attribute__((aligned(16))) unsigned char lds_raw[];
    LAS unsigned char* lds = (LAS unsigned char*)lds_raw;
    volatile LAS unsigned* MISC = (volatile LAS unsigned*)(lds + MISC_OFF);
    const int G = gridDim.x, bx = blockIdx.x;
#define NGW (G * NWAVES)
#define NGT (G * NTHREADS)
    gu32* ctl = (gu32*)(args.ws + cfg::WS_CTL);
    for (int u = threadIdx.x; u < (LDS_BYTES - MISC_OFF) / 4; u += NTHREADS) ((LAS unsigned*)(lds + MISC_OFF))[u] = 0u;
    __syncthreads();
    (void)xcd_barrier_post((unsigned*)ctl + 4096, MISC + 8);
#define PH_ON true
#define PH_END do { XcdBarrier b_; b_.bar = (unsigned*)(((KArgs)__builtin_amdgcn_kernarg_segment_ptr())->ws + cfg::WS_CTL) + 4096; b_.x = xb_xcc_id(); b_.st = (volatile LAS unsigned*)(lds + MISC_OFF) + 8; \
        xcd_barrier(b_); if ((PROBE_MASK >> 4) & 1) xcd_barrier(b_); } while (0)
#define PH_BEGIN(grp) if (PH_ON) for (int rep_ = 0; rep_ < ((((PROBE_MASK) >> (grp)) & 1) ? 2 : 1); ++rep_) { PH_VARS
#define PH_VARS int tid_ = threadIdx.x; asm volatile("" : "+v"(tid_)); const int tid = tid_, lane = tid & 63, wave = __builtin_amdgcn_readfirstlane(tid >> 6); \
    const int gw = bx * NWAVES + wave, gt = bx * NTHREADS + tid; (void)gw; (void)gt; (void)lane; \
    KArgs ka = (KArgs)__builtin_amdgcn_kernarg_segment_ptr(); asm volatile("" : "+s"(ka)); unsigned char* ws = ka->ws; float* out = ka->out; (void)out;
#define Wqkv ((bf16*)(ws + cfg::WS_WQKV))
#define Woa ((bf16*)(ws + cfg::WS_WOA))
#define Winb ((bf16*)(ws + cfg::WS_WINB))
#define Wob ((bf16*)(ws + cfg::WS_WOB))
#define Wq ((bf16*)(ws + cfg::WS_WQ))
#define Wkv ((bf16*)(ws + cfg::WS_WKV))
#define Wo ((bf16*)(ws + cfg::WS_WO))
#define Wup ((bf16*)(ws + cfg::WS_WUP))
#define Wdn ((bf16*)(ws + cfg::WS_WDN))
#define Y ((float*)(ws + cfg::WS_Y))
#define YB ((bf16*)(ws + cfg::WS_YB))
#define SSQ ((float*)(ws + cfg::WS_SSQ))
#define SSQS ((float*)(ws + cfg::WS_SSQS))
#define MEMB ((bf16*)(ws + cfg::WS_MEMB))
#define SSQM ((float*)(ws + cfg::WS_SSQM))
#define KVB ((bf16*)(ws + cfg::WS_KVB))
#define CKV ((bf16*)(ws + cfg::WS_CKV))
#define BIG ((bf16*)(ws + cfg::WS_BIG))
#define ACT ((bf16*)(ws + cfg::WS_ACT))
#define QM ((bf16*)(ws + cfg::WS_QM))
#define OM ((bf16*)(ws + cfg::WS_OM))
#define OG ((bf16*)(ws + cfg::WS_OG))
#define LSE ((float*)(ws + cfg::WS_LSE))
#define MRG ((bf16*)(ws + cfg::WS_MRG))
#define QKVS ((float*)(ws + cfg::WS_QKVS))
#define U3S ((float*)(ws + cfg::WS_U3S))
#define US ((float*)(ws + cfg::WS_US))
#define WQNT ((bf16*)(ws + cfg::WS_WQNT))
#define MKT ((bf16*)(ws + cfg::WS_MKT))
#define VWT ((bf16*)(ws + cfg::WS_VWT))
#define Ys (Y + (size_t)cfg::MP * 2048)
#define YBs (YB + (size_t)cfg::MP * 2048)
    LAS float* const rstab = (LAS float*)(lds + 131072);

    PH_BEGIN(0)
        LAS float* scr = (LAS float*)(lds + wave * 17408);
        run_slot(0, gw, NGW, ka, ws, out, scr, lane);
        for (int m = gw; m < cfg::MT + cfg::MM; m += NGW) {
            if (m < cfg::MP) p0_row(ka->in[0] + (size_t)m * 2048, nullptr, YB + (size_t)m * 2048, SSQ + (size_t)m * 32, 32, lane);
            else if (m < cfg::MT) { const int s = m - cfg::MP; p0_row(ka->in[1] + (size_t)s * 2048, Ys + (size_t)s * 2048, YBs + (size_t)s * 2048, SSQS + (size_t)s * 128, 128, lane); }
            else { const int s = m - cfg::MT; p0_row(ka->in[2] + (size_t)s * 2048, nullptr, MEMB + (size_t)s * 2048, SSQM + (size_t)s * 32, 32, lane); }
        }
    }
    PH_END;

    PH_BEGIN(1)
        pg8::Gemm g{MEMB, Wkv, cfg::MM, 16384, 2048}; pg8::StaticOrder S; S.init(cfg::MM, 16384, G, bx);
        ep::EpiKV E{KVB, SSQM, out, (LAS float*)(lds + 131072 + 1024)};
        pg8::gemm_phase<ep::EpiKV, pg8::StaticOrder, true, true>(lds, g, S, E);
    }
    if (MK_CUTS_ON) { PH_END; }

    for (int layer = 0; layer < 4; ++layer) {
        const int j = layer >> 1;
        if ((layer & 1) == 0) {
            PH_BEGIN(1)
                { pg8::Gemm g{YB, Wqkv + (size_t)j * 4608 * 2048, cfg::MP, cfg::NQKV, 2048}; pg8::StaticOrder S; S.init(cfg::MP, cfg::NQKV, G, bx);
                  ep::EpiQKV E{BIG, SSQ, out, j, 0.08838834764831845f * cfg::LOG2E, (LAS float*)(lds + 131072 + 1024)};
                  pg8::gemm_phase<ep::EpiQKV, pg8::StaticOrder, true, true>(lds, g, S, E); }
                sample_rstd_table(rstab, SSQS);
                SEpiF32 se{QKVS, cfg::NQKV, rstab, out, 1, j};
                sample_gemm64(lds, YBs, Wqkv + (size_t)j * 4608 * 2048, cfg::NQKV, 2048, G == 256 ? bx - 64 : bx, G == 256 ? 192 : G, se);
                if (G == 256 && bx >= 64) run_slot(layer == 0 ? 1 : 4, (bx - 64) * NWAVES + wave, 192 * NWAVES, ka, ws, out, (LAS float*)(lds + wave * 17408), lane);
                else if (G != 256) run_slot(layer == 0 ? 1 : 4, gw, NGW, ka, ws, out, (LAS float*)(lds + wave * 17408), lane);
                if (PROBE_MASK) __syncthreads();
            }
            PH_END;
            PH_BEGIN(2)
                dattn_phase(lds, BIG, OG, LSE, (G % 8 == 0) ? (bx % 8) * (G / 8) + bx / 8 : bx, G);
                { const int tw = wave % 3, half = wave / 3;
                  for (int rnd = 0; rnd * 3 * G < 768; ++rnd) { const int task = bx + G * tw + rnd * 3 * G; const bool on = (wave < 6) && (task < 768);
                      LAS float* xch = (LAS float*)(lds + 8192) + tw * 260;
                      if (on) dattn_sample_half((LAS float*)(lds + wave * 1024), xch, QKVS, ka->in[3], ka->in[4], ka->in[5], j, task, half, lane);
                      __syncthreads();
                      if (on && half == 0) dattn_sample_merge(xch, OG, LSE, task, lane);
                      __syncthreads(); } }
            }
            PH_END;
            PH_BEGIN(2)
                for (int i0 = gt; i0 < cfg::MT * 64; i0 += 2 * NGT) {
                    float l0[2], l1[2], l2[2]; u32x4g a[2], b[2], c[2]; bool on[2];
#pragma unroll
                    for (int q = 0; q < 2; ++q) { const int i = i0 + q * NGT; on[q] = i < cfg::MT * 64; const int ii = on[q] ? i : i0; const int row = ii >> 6, c8 = (ii & 63) * 8, h = c8 >> 7;
                        l0[q] = LSE[((size_t)0 * cfg::MT + row) * 4 + h]; l1[q] = LSE[((size_t)1 * cfg::MT + row) * 4 + h]; l2[q] = LSE[((size_t)2 * cfg::MT + row) * 4 + h];
                        a[q] = *(const GAS u32x4g*)(OG + ((size_t)0 * cfg::MT + row) * 512 + c8); b[q] = *(const GAS u32x4g*)(OG + ((size_t)1 * cfg::MT + row) * 512 + c8); c[q] = *(const GAS u32x4g*)(OG + ((size_t)2 * cfg::MT + row) * 512 + c8); }
#pragma unroll
                    for (int q = 0; q < 2; ++q) { if (!on[q]) continue; const int i = i0 + q * NGT, row = i >> 6, c8 = (i & 63) * 8;
                        const float mx = fmaxf(l0[q], fmaxf(l1[q], l2[q])); float w0 = __expf(l0[q] - mx), w1 = __expf(l1[q] - mx), w2 = __expf(l2[q] - mx); const float inv = 1.0f / (w0 + w1 + w2); w0 *= inv; w1 *= inv; w2 *= inv;
                        u32x4g o;
                        o.x = cvtpk(w0 * bf_lo(a[q].x) + w1 * bf_lo(b[q].x) + w2 * bf_lo(c[q].x), w0 * bf_hi(a[q].x) + w1 * bf_hi(b[q].x) + w2 * bf_hi(c[q].x));
                        o.y = cvtpk(w0 * bf_lo(a[q].y) + w1 * bf_lo(b[q].y) + w2 * bf_lo(c[q].y), w0 * bf_hi(a[q].y) + w1 * bf_hi(b[q].y) + w2 * bf_hi(c[q].y));
                        o.z = cvtpk(w0 * bf_lo(a[q].z) + w1 * bf_lo(b[q].z) + w2 * bf_lo(c[q].z), w0 * bf_hi(a[q].z) + w1 * bf_hi(b[q].z) + w2 * bf_hi(c[q].z));
                        o.w = cvtpk(w0 * bf_lo(a[q].w) + w1 * bf_lo(b[q].w) + w2 * bf_lo(c[q].w), w0 * bf_hi(a[q].w) + w1 * bf_hi(b[q].w) + w2 * bf_hi(c[q].w));
                        *(GAS u32x4g*)(MRG + (size_t)row * 512 + c8) = o; } }
            }
            PH_END;
            PH_BEGIN(5)
                { pg8::Gemm g{MRG, Woa + (size_t)j * 2048 * 512, cfg::MP, 2048, 512}; pg8::StaticOrder S; S.init(cfg::MP, 2048, G, bx);
                  ep::EpiResid E{rep_ ? BIG : YB, rep_ ? (float*)(BIG + (size_t)32 * 1024 * 1024) : SSQ};
                  pg8::gemm_phase<ep::EpiResid, pg8::StaticOrder, true, true>(lds, g, S, E); }
                SEpiResid se{Ys, YBs, SSQS};
                if (rep_ == 0) for (int sr_ = 0; sr_ < (((PROBE_MASK) >> 6) & 1) + 1; ++sr_) { SEpiResid se2{sr_ ? (float*)(BIG + (size_t)40 * 1024 * 1024) : Ys, sr_ ? BIG + (size_t)60 * 1024 * 1024 : YBs, sr_ ? (float*)(BIG + (size_t)70 * 1024 * 1024) : SSQS}; sample_gemm(lds, MRG + (size_t)cfg::MP * 512, Woa + (size_t)j * 2048 * 512, 2048, 512, bx, G, se2, sr_ ? PROBE_SMODE : 0); }
                if (layer == 0 && rep_ == 0) {
                    ep::PrepOrder S{0, bx, G, KVB, WQNT}; pg8::Gemm g{nullptr, nullptr, 256, 2048, 512, 4096, 2048};
                    ep::EpiPrep E{MKT, 2048, 0.04419417382415922f * cfg::LOG2E, (size_t)1024 * 2048, (size_t)256 * 2048};
                    pg8::gemm_phase<ep::EpiPrep, ep::PrepOrder, true, true>(lds, g, S, E);
                    ep::PrepOrder S1{1, (G == 256) ? bx - 128 : bx, (G == 256) ? 128 : G, KVB, Wo}; pg8::Gemm g1{nullptr, nullptr, 2048, 256, 512, 2048, 4096};
                    ep::EpiPrep E1{VWT, 1024, 1.0f, (size_t)2048 * 1024, (size_t)256};
                    pg8::gemm_phase<ep::EpiPrep, ep::PrepOrder, true, true>(lds, g1, S1, E1); }
            }
            PH_END;
        } else {
            PH_BEGIN(1)
                { pg8::Gemm g{YB, Winb + (size_t)j * 6144 * 2048, cfg::MP, cfg::NINB, 2048}; pg8::StaticOrder S; S.init(cfg::MP, cfg::NINB, G, bx);
                  ep::EpiScale E{BIG, cfg::NINB, SSQ, 1.f, (LAS float*)(lds + 131072 + 1024)};
                  pg8::gemm_phase<ep::EpiScale, pg8::StaticOrder, true, true>(lds, g, S, E); }
                sample_rstd_table(rstab, SSQS);
                SEpiF32 se{U3S, cfg::NINB, rstab, out, 0, j};
                sample_gemm64(lds, YBs, Winb + (size_t)j * 6144 * 2048, cfg::NINB, 2048, bx, G, se);
            }
            PH_END;
            PH_BEGIN(3)
                const float* cw = ka->in[17] + (size_t)j * 3 * 2048;
                for (int i = gt; i < 512 * 256; i += NGT) { const int chunk = i >> 8, c8 = (i & 255) * 8, row0 = chunk * 16, t0 = row0 & 2047, nb = row0 >> 11;
                    float w0[8], w1[8], w2[8], p2[8], p1[8];
#pragma unroll
                    for (int e = 0; e < 8; ++e) { w0[e] = cw[c8 + e]; w1[e] = cw[2048 + c8 + e]; w2[e] = cw[4096 + c8 + e]; p2[e] = 0.f; p1[e] = 0.f; }
                    if (t0 != 0) { const bf16* rp = BIG + (size_t)(row0 - 2) * cfg::NINB + c8;
                        float g0[8], v0[8], g1[8], v1[8];
                        unpack8(g0, *(const GAS u32x4g*)(rp + 2048)); unpack8(v0, *(const GAS u32x4g*)(rp + 4096)); unpack8(g1, *(const GAS u32x4g*)(rp + cfg::NINB + 2048)); unpack8(v1, *(const GAS u32x4g*)(rp + cfg::NINB + 4096));
#pragma unroll
                        for (int e = 0; e < 8; ++e) { p2[e] = g0[e] * v0[e]; p1[e] = g1[e] * v1[e]; } }
                    for (int q0 = 0; q0 < 16; q0 += 4) {
                        u32x4g gbv[4], gcv[4], vlv[4];
#pragma unroll
                        for (int jq = 0; jq < 4; ++jq) { const bf16* rp = BIG + (size_t)(row0 + q0 + jq) * cfg::NINB + c8;
                            gbv[jq] = __builtin_nontemporal_load((const GAS u32x4g*)rp); gcv[jq] = __builtin_nontemporal_load((const GAS u32x4g*)(rp + 2048)); vlv[jq] = __builtin_nontemporal_load((const GAS u32x4g*)(rp + 4096)); }
#pragma unroll
                        for (int jq = 0; jq < 4; ++jq) { const int row = row0 + q0 + jq, t = t0 + q0 + jq;
                            float cv[8], gbf[8], o[8], gcf[8], vlf[8];
                            unpack8(gbf, gbv[jq]); unpack8(gcf, gcv[jq]); unpack8(vlf, vlv[jq]);
#pragma unroll
                            for (int e = 0; e < 8; ++e) cv[e] = gcf[e] * vlf[e];
#pragma unroll
                            for (int e = 0; e < 8; ++e) { o[e] = gbf[e] * (w0[e] * p2[e] + w1[e] * p1[e] + w2[e] * cv[e]); p2[e] = p1[e]; p1[e] = cv[e]; }
                            u32x4g w; w.x = cvtpk(o[0], o[1]); w.y = cvtpk(o[2], o[3]); w.z = cvtpk(o[4], o[5]); w.w = cvtpk(o[6], o[7]);
                            *(GAS u32x4g*)(MRG + (size_t)row * 2048 + c8) = w;
                            if (t >= 2046) { float* d = out + cfg::O_PCB + ((size_t)(j * 4 + nb) * 2 + (t - 2046)) * 2048 + c8;
                                *(GAS f32x4*)d = (f32x4){cv[0], cv[1], cv[2], cv[3]}; *(GAS f32x4*)(d + 4) = (f32x4){cv[4], cv[5], cv[6], cv[7]}; } } } }
                for (int i = gt; i < 8 * 512; i += NGT) { const int n = i >> 9, c4 = (i & 511) * 4;
                    const f32x4 w0 = *(const GAS f32x4*)(cw + c4), w1 = *(const GAS f32x4*)(cw + 2048 + c4), w2 = *(const GAS f32x4*)(cw + 4096 + c4);
                    const float* st = ka->in[6] + ((size_t)(j * 8 + n) * 2) * 2048 + c4;
                    f32x4 p2 = *(const GAS f32x4*)st, p1 = *(const GAS f32x4*)(st + 2048);
                    for (int t = 0; t < 8; ++t) { const float* rp = U3S + (size_t)(n * 8 + t) * cfg::NINB + c4;
                        const f32x4 gb = *(const GAS f32x4*)rp, gc = *(const GAS f32x4*)(rp + 2048), vl = *(const GAS f32x4*)(rp + 4096);
                        const f32x4 cv = gc * vl; const f32x4 o = gb * (w0 * p2 + w1 * p1 + w2 * cv); p2 = p1; p1 = cv;
                        u32x2g w; w.x = cvtpk(o[0], o[1]); w.y = cvtpk(o[2], o[3]); *(GAS u32x2g*)(MRG + (size_t)(cfg::MP + n * 8 + t) * 2048 + c4) = w;
                        if (t >= 6) *(GAS f32x4*)(out + cfg::O_SCB + ((size_t)(j * 8 + n) * 2 + (t - 6)) * 2048 + c4) = cv; } }
            }
            PH_END;
            PH_BEGIN(5)
                { pg8::Gemm g{MRG, Wob + (size_t)j * 2048 * 2048, cfg::MP, 2048, 2048}; pg8::StaticOrder S; S.init(cfg::MP, 2048, G, bx);
                  ep::EpiResid E{rep_ ? BIG : YB, rep_ ? (float*)(BIG + (size_t)32 * 1024 * 1024) : SSQ};
                  pg8::gemm_phase<ep::EpiResid, pg8::StaticOrder, true, true>(lds, g, S, E); }
                SEpiResid se{Ys, YBs, SSQS};
                if (rep_ == 0) for (int sr_ = 0; sr_ < (((PROBE_MASK) >> 6) & 1) + 1; ++sr_) { SEpiResid se2{sr_ ? (float*)(BIG + (size_t)40 * 1024 * 1024) : Ys, sr_ ? BIG + (size_t)60 * 1024 * 1024 : YBs, sr_ ? (float*)(BIG + (size_t)70 * 1024 * 1024) : SSQS}; sample_gemm(lds, MRG + (size_t)cfg::MP * 2048, Wob + (size_t)j * 2048 * 2048, 2048, 2048, bx, G, se2, sr_ ? PROBE_SMODE : 0); }
            }
            PH_END;
        }
        PH_BEGIN(1)
            const float qs = 0.04419417382415922f * cfg::LOG2E;
            { pg8::Gemm g{YB, MKT + (size_t)(layer & 1) * 4 * 1024 * 2048, cfg::MP, 1024, 2048}; ep::ScoreOrder S; S.init(cfg::MP, 1024, G, bx); S.MK = g.Bt;
              ep::EpiSoftmax E{QM, SSQ, (LAS float*)(lds + 131072 + 1024)};
              pg8::gemm_phase<ep::EpiSoftmax, ep::ScoreOrder, false, true>(lds, g, S, E); }
            if (G != 256 || bx >= 128) { const int w = (G == 256) ? bx - 128 : bx, nw = (G == 256) ? 128 : G;
                if (layer < 3) { ep::PrepOrder S{0, w, nw, KVB + (size_t)(layer + 1) * cfg::MM * 4096, WQNT + (size_t)(layer + 1) * 2048 * 2048}; pg8::Gemm g{nullptr, nullptr, 256, 2048, 512, 4096, 2048};
                    ep::EpiPrep E{MKT + (size_t)((layer + 1) & 1) * 4 * 1024 * 2048, 2048, qs, (size_t)1024 * 2048, (size_t)256 * 2048};
                    pg8::gemm_phase<ep::EpiPrep, ep::PrepOrder, true, true>(lds, g, S, E);
                    ep::PrepOrder S1{1, w, nw, KVB + (size_t)(layer + 1) * cfg::MM * 4096, Wo + (size_t)(layer + 1) * 2048 * 2048}; pg8::Gemm g1{nullptr, nullptr, 2048, 256, 512, 2048, 4096};
                    ep::EpiPrep E1{VWT + (size_t)((layer + 1) & 1) * 4 * 2048 * 1024, 1024, 1.0f, (size_t)2048 * 1024, (size_t)256};
                    pg8::gemm_phase<ep::EpiPrep, ep::PrepOrder, true, true>(lds, g1, S1, E1); }
                sample_rstd_table(rstab, SSQS);
                SEpiBf16 se{QM + (size_t)cfg::MP * 2048, 2048, rstab, qs};
                sample_gemm(lds, YBs, Wq + (size_t)layer * 2048 * 2048, 2048, 2048, w, nw, se);
                if (layer == 3) { int t2_ = threadIdx.x; asm volatile("" : "+v"(t2_)); KArgs k2 = (KArgs)__builtin_amdgcn_kernarg_segment_ptr(); asm volatile("" : "+s"(k2));
                    const int w2_ = __builtin_amdgcn_readfirstlane(t2_ >> 6); run_slot(11, w * NWAVES + w2_, nw * NWAVES, k2, k2->ws, k2->out, (LAS float*)(lds + w2_ * 17408), t2_ & 63); } }
        }
        PH_END;
        PH_BEGIN(2)
            const int vcu = bx;
            for (int s = vcu; s < 32; s += G) { const int n = s >> 2, h = s & 3;
                const bf16* kb = CKV + ((size_t)(layer * 8 + n) * 256) * 4096 + h * 512;
                memattn_unit<false>(lds, QM + h * 512, cfg::MP + n * 8, true, kb, kb + 2048, OM + h * 512); }
            if (G == 256 && vcu >= 32) run_slot(7 + layer, (vcu - 32) * NWAVES + wave, 224 * NWAVES, ka, ws, out, (LAS float*)(lds + wave * 17408), lane);
            else if (G != 256) run_slot(7 + layer, gw, NGW, ka, ws, out, (LAS float*)(lds + wave * 17408), lane);
            if (PROBE_MASK) __syncthreads();
        }
        PH_END;
        PH_BEGIN(5)
            { pg8::Gemm g{QM  , VWT + (size_t)(layer & 1) * 4 * 2048 * 1024, cfg::MP, 2048, 1024}; ep::OutOrder S; S.init(cfg::MP, 2048, G, bx); S.VW = g.Bt;
              ep::EpiResid E{rep_ ? BIG : YB, rep_ ? (float*)(BIG + (size_t)32 * 1024 * 1024) : SSQ};
              pg8::gemm_phase<ep::EpiResid, ep::OutOrder, true, true>(lds, g, S, E); }
            SEpiResid se{Ys, YBs, SSQS};
            if (rep_ == 0) for (int sr_ = 0; sr_ < (((PROBE_MASK) >> 6) & 1) + 1; ++sr_) { SEpiResid se2{sr_ ? (float*)(BIG + (size_t)40 * 1024 * 1024) : Ys, sr_ ? BIG + (size_t)60 * 1024 * 1024 : YBs, sr_ ? (float*)(BIG + (size_t)70 * 1024 * 1024) : SSQS}; sample_gemm(lds, OM + (size_t)cfg::MP * 2048, Wo + (size_t)layer * 2048 * 2048, 2048, 2048, bx, G, se2, sr_ ? PROBE_SMODE : 0); }
        }
        PH_END;
        PH_BEGIN(1)
            { pg8::Gemm g{YB, Wup + (size_t)layer * 11264 * 2048, cfg::MP, cfg::UP, 2048}; pg8::StaticOrder S; S.init(cfg::MP, cfg::UP, G, bx);
              ep::EpiUpConv E{ACT, SSQ, out, (float*)(ws + cfg::WS_HALO), ka->in[23] + (size_t)layer * 3 * cfg::UP, layer, (LAS float*)(lds + 133120), (LAS float*)(lds + 131072 + 1024)};
              pg8::gemm_phase<ep::EpiUpConv, pg8::StaticOrder, true, true>(lds, g, S, E); }
            sample_rstd_table(rstab, SSQS);
            sample_up_conv(lds, YBs, Wup + (size_t)layer * 11264 * 2048, bx, G, rstab, ka->in[23] + (size_t)layer * 3 * cfg::UP, ka->in[7] + (size_t)layer * 8 * 2 * cfg::UP, out + cfg::O_SFC + (size_t)layer * 8 * 2 * cfg::UP, ACT + (size_t)cfg::MP * cfg::DFF);
            { const int slot = layer == 0 ? 2 : (layer == 1 ? 3 : (layer == 2 ? 5 : 6));
              if (G == 256 && bx >= 128) run_slot(slot, (bx - 128) * NWAVES + wave, 128 * NWAVES, ka, ws, out, (LAS float*)(lds + wave * 17408), lane);
              else if (G != 256) run_slot(slot, gw, NGW, ka, ws, out, (LAS float*)(lds + wave * 17408), lane); }
            if (PROBE_MASK) __syncthreads();
        }
        PH_END;
        PH_BEGIN(5)
            if (rep_ == 0) {
                int t3_ = threadIdx.x; asm volatile("" : "+v"(t3_));
                const float* hal = (const float*)(ws + cfg::WS_HALO); const float* cw = ka->in[23] + (size_t)layer * 3 * cfg::UP;
                int pm_lo = 0, pm_hi = 32;
                if (G == 256) { const int wgid = (bx % 8) * 32 + bx / 8, nig = pg8::WGM * 8; pm_lo = (wgid / nig) * pg8::WGM + (wgid % nig) % pg8::WGM; pm_hi = pm_lo + 1; }
                for (int pm = pm_lo; pm < pm_hi; ++pm) {
                    if ((pm & 7) == 0) continue;
                    for (int i = t3_; i < 1408; i += NTHREADS) { const int c4 = i * 4, colA = 256 * (c4 >> 7) + (c4 & 127);
                        const float* hp = hal + (size_t)((pm - 1) * 4 + 2) * cfg::UP + colA; const float* hc = hal + (size_t)(pm * 4) * cfg::UP + colA;
                        const f32x4 am2 = *(const GAS f32x4*)hp, am1 = *(const GAS f32x4*)(hp + cfg::UP), a0 = *(const GAS f32x4*)hc, a1 = *(const GAS f32x4*)(hc + cfg::UP);
                        const f32x4 bm2 = *(const GAS f32x4*)(hp + 128), bm1 = *(const GAS f32x4*)(hp + cfg::UP + 128), b0 = *(const GAS f32x4*)(hc + 128), b1 = *(const GAS f32x4*)(hc + cfg::UP + 128);
                        const f32x4 wa0 = *(const GAS f32x4*)(cw + c4), wa1 = *(const GAS f32x4*)(cw + cfg::UP + c4), wa2 = *(const GAS f32x4*)(cw + 2 * cfg::UP + c4);
                        const f32x4 wb0 = *(const GAS f32x4*)(cw + cfg::DFF + c4), wb1 = *(const GAS f32x4*)(cw + cfg::UP + cfg::DFF + c4), wb2 = *(const GAS f32x4*)(cw + 2 * cfg::UP + cfg::DFF + c4);
#pragma unroll
                        for (int rr = 0; rr < 2; ++rr) {
                            const f32x4 va = rr == 0 ? wa0 * am2 + wa1 * am1 + wa2 * a0 : wa0 * am1 + wa1 * a0 + wa2 * a1;
                            const f32x4 vb = rr == 0 ? wb0 * bm2 + wb1 * bm1 + wb2 * b0 : wb0 * bm1 + wb1 * b0 + wb2 * b1;
                            f32x4 o; o[0] = va[0] / (1.0f + __expf(-va[0])) * vb[0]; o[1] = va[1] / (1.0f + __expf(-va[1])) * vb[1]; o[2] = va[2] / (1.0f + __expf(-va[2])) * vb[2]; o[3] = va[3] / (1.0f + __expf(-va[3])) * vb[3];
                            u32x2g w; w.x = cvtpk(o[0], o[1]); w.y = cvtpk(o[2], o[3]); *(GAS u32x2g*)(ACT + (size_t)(pm * 256 + rr) * cfg::DFF + c4) = w; } } }
                asm volatile("s_waitcnt vmcnt(0)" ::: "memory"); __syncthreads();
            }
            { pg8::Gemm g{ACT, Wdn + (size_t)layer * 2048 * 5632, cfg::MP, 2048, cfg::DFF}; pg8::StaticOrder S; S.init(cfg::MP, 2048, G, bx);
              ep::EpiResid E{rep_ ? BIG : YB, rep_ ? (float*)(BIG + (size_t)32 * 1024 * 1024) : SSQ};
              pg8::gemm_phase<ep::EpiResid, pg8::StaticOrder, true, true>(lds, g, S, E); }
            SEpiResid se{Ys, YBs, SSQS};
            if (rep_ == 0) for (int sr_ = 0; sr_ < (((PROBE_MASK) >> 6) & 1) + 1; ++sr_) { SEpiResid se2{sr_ ? (float*)(BIG + (size_t)40 * 1024 * 1024) : Ys, sr_ ? BIG + (size_t)60 * 1024 * 1024 : YBs, sr_ ? (float*)(BIG + (size_t)70 * 1024 * 1024) : SSQS}; sample_gemm(lds, ACT + (size_t)cfg::MP * cfg::DFF, Wdn + (size_t)layer * 2048 * 5632, 2048, cfg::DFF, bx, G, se2, sr_ ? PROBE_SMODE : 0); }
        }
        PH_END;
    }
    PH_BEGIN(3)
        const float* gf = ka->in[13];
        for (int m = gw; m < cfg::MT; m += NGW) { f32x4 v[8]; float s = 0.f;
            if (m < cfg::MP) { const GAS u32x2g* yr = (const GAS u32x2g*)(YB + (size_t)m * 2048) + lane;
#pragma unroll
                for (int q = 0; q < 8; ++q) { const u32x2g w = yr[64 * q]; v[q] = (f32x4){bf_lo(w.x), bf_hi(w.x), bf_lo(w.y), bf_hi(w.y)}; } }
            else { const GAS f32x4* yr = (const GAS f32x4*)(Y + (size_t)m * 2048) + lane;
#pragma unroll
                for (int q = 0; q < 8; ++q) v[q] = yr[64 * q]; }
#pragma unroll
            for (int q = 0; q < 8; ++q) s += (v[q].x * v[q].x + v[q].y * v[q].y) + (v[q].z * v[q].z + v[q].w * v[q].w);
            const float rs = 1.0f / sqrtf(wave_sum(s) * (1.0f / 2048.0f) + cfg::EPS);
            GAS f32x4* o = (GAS f32x4*)(out + (m < cfg::MP ? cfg::O_YP + (size_t)m * 2048 : cfg::O_YS + (size_t)(m - cfg::MP) * 2048)) + lane;
#pragma unroll
            for (int q = 0; q < 8; ++q) { const f32x4 gg = ((const GAS f32x4*)gf)[lane + 64 * q]; __builtin_nontemporal_store(v[q] * rs * gg, o + 64 * q); } }
    }
#undef PH_ON
#undef PH_END
#undef PH_VARS
#undef PH_BEGIN
#undef Wqkv
#undef Woa
#undef Winb
#undef Wob
#undef Wq
#undef Wkv
#undef Wo
#undef Wup
#undef Wdn
#undef Y
#undef YB
#undef SSQ
#undef SSQS
#undef MEMB
#undef SSQM
#undef KVB
#undef CKV
#undef BIG
#undef ACT
#undef QM
#undef OM
#undef OG
#undef LSE
#undef MRG
#undef QKVS
#undef U3S
#undef US
#undef Ys
#undef WQNT
#undef MKT
#undef VWT
#undef YBs
}

#ifndef MK_CUTS
#define MK_CUTS 0
#endif
extern "C" void kernel_launch(void* const* d_in, const int* in_sizes, int n_in, void* d_out, int out_size, void* d_ws, size_t ws_size, hipStream_t stream) {
    static int grid = 0;
    if (grid == 0) {
        if (n_in != 25 || (size_t)out_size != cfg::O_END || ws_size < cfg::WS_END) { fprintf(stderr, "kernel_launch: unexpected problem: n_in %d out %d ws %zu (need %zu)\n", n_in, out_size, ws_size, (size_t)cfg::WS_END); grid = -1; return; }
        int dev = 0, cus = 0, per_cu = 0;
        if (hipGetDevice(&dev) != hipSuccess || hipDeviceGetAttribute(&cus, hipDeviceAttributeMultiprocessorCount, dev) != hipSuccess) { grid = -1; return; }
        if (hipFuncSetAttribute((const void*)mk_fwd, hipFuncAttributeMaxDynamicSharedMemorySize, LDS_BYTES) != hipSuccess) { fprintf(stderr, "kernel_launch: hipFuncSetAttribute failed\n"); grid = -1; return; }
        if (hipOccupancyMaxActiveBlocksPerMultiprocessor(&per_cu, (const void*)mk_fwd, NTHREADS, LDS_BYTES) != hipSuccess || per_cu < 1) { fprintf(stderr, "kernel_launch: occupancy query says %d\n", per_cu); }
        (void)hipGetLastError();
        grid = cus;
    }
    if (grid < 0) return;
    (void)hipMemsetAsync((char*)d_ws + cfg::WS_CTL, 0, cfg::CTL_ZERO_BYTES, stream);
    Args a{};
    for (int i = 0; i < 25; ++i) a.in[i] = (const float*)d_in[i];
    a.out = (float*)d_out; a.ws = (unsigned char*)d_ws;
#if MK_CUTS == 0
    a.ph_lo = 0; a.ph_hi = 1000;
    hipLaunchKernelGGL(mk_fwd, dim3(grid), dim3(NTHREADS), LDS_BYTES, stream, a);
#else
    for (int p = 0; p < 2 + 2 * 10 + 2 * 9 + 1; ++p) { a.ph_lo = p; a.ph_hi = p + 1; hipLaunchKernelGGL(mk_fwd, dim3(grid), dim3(NTHREADS), LDS_BYTES, stream, a); }
#endif
}
```

```cpp
#include <hip/hip_runtime.h>
#include <cstdio>
#include <cstdint>
namespace pg8 {
#define PG8_LAS __attribute__((address_space(3)))
typedef unsigned short bf16_t;
typedef short bf16x8 __attribute__((ext_vector_type(8)));
typedef float f32x4 __attribute__((ext_vector_type(4)));
typedef unsigned u32x4 __attribute__((ext_vector_type(4)));
constexpr int BM = 256, BK = 64, HALF = 128, HTB = HALF * BK * 2  , STAGE_BYTES = 8 * HTB, NXCD = 8, WGM = 4;

__host__ __device__ __forceinline__ int lds_byte(int r, int c) { const int st = (r >> 4) * 2 + (c >> 5), rr = r & 15, cc = c & 31, ob = rr * 64 + cc * 2; return st * 1024 + (ob ^ (((ob >> 9) & 1) << 5)); }
__host__ __device__ __forceinline__ void stage_rc(int b, int& R, int& C) { const int st = b / 1024, sb = b % 1024, swz = sb ^ (((sb >> 9) & 1) << 5); R = (st >> 1) * 16 + swz / 64; C = (st & 1) * 32 + (swz % 64) / 2; }
__host__ __device__ __forceinline__ int perm32(int rho) { const int n = rho >> 4, i = rho & 15; return 8 * (i >> 2) + 4 * n + (i & 3); }

struct Unit { int pm, pn, z; };
struct Gemm { const bf16_t* A; const bf16_t* Bt; int M, N, K; int lda = 0, ldb = 0; };

struct StaticOrder {
    int nM, nN, nwg, G, c, wgm;
    __host__ __device__ void init(int M, int N, int G_, int c_, int wgm_ = WGM) { nM = M / BM; nN = N / BM; nwg = nM * nN; G = G_; c = c_; wgm = wgm_; }
    __host__ __device__ bool next(int i, Unit& u) const {
        const long L = (long)i * G + c; if (L >= nwg) return false;
        int wgid = (int)L; { const int q = nwg / NXCD, r = nwg % NXCD, xcd = wgid % NXCD, off = wgid / NXCD; wgid = (xcd < r ? xcd * (q + 1) : r * (q + 1) + (xcd - r) * q) + off; }
        const int nig = wgm * nN, gid = wgid / nig, fm = gid * wgm, gsz = (nM - fm) < wgm ? (nM - fm) : wgm;
        u.pm = fm + ((wgid % nig) % gsz); u.pn = (wgid % nig) / gsz; u.z = 0; return true;
    }
    __device__ __forceinline__ void a_ready(const Unit&) const {}
    __device__ __forceinline__ void done(const Unit&) const {}
    __device__ __forceinline__ const char* abase(const Gemm& g, const Unit& u) const { return (const char*)g.A + (size_t)u.pm * BM * (g.lda ? g.lda : g.K) * 2; }
    __device__ __forceinline__ const char* bbase(const Gemm& g, const Unit& u) const { return (const char*)g.Bt + (size_t)u.pn * BM * (g.ldb ? g.ldb : g.K) * 2; }
};

__device__ __forceinline__ unsigned cvt_pk_bf16(float lo, float hi) { unsigned r; asm volatile("v_cvt_pk_bf16_f32 %0, %1, %2" : "=v"(r) : "v"(lo), "v"(hi)); return r; }
typedef float f32x2 __attribute__((ext_vector_type(2)));
__device__ __forceinline__ void ep_rstd_table(const float* ssq, PG8_LAS float* rt, int pm, int tid);
template <class Epi, class Sched, bool ALIGN_EPI = false, bool SP2 = false>
__device__ __forceinline__ void gemm_phase(PG8_LAS unsigned char* lds, const Gemm g, const Sched& S, const Epi& E) {
    int tid_ = threadIdx.x; asm volatile("" : "+v"(tid_));
    const int tid = tid_, wid = __builtin_amdgcn_readfirstlane(tid >> 6), lane = tid & 63, wr = wid >> 2, wc = wid & 3, fr = lane & 15, fq = lane >> 4;
    const int K = g.K, nt = K / BK, lda = g.lda ? g.lda : K, ldb = g.ldb ? g.ldb : K;
    unsigned voffA[2], voffB[2];
#pragma unroll
    for (int i = 0; i < 2; ++i) { int R, C; stage_rc(tid * 16 + i * 8192, R, C); const int Rb = Epi::PERM ? ((R & ~31) + perm32(R & 31)) : R;
        voffA[i] = (unsigned)(R * lda + C) * 2u; voffB[i] = (unsigned)(Rb * ldb + C) * 2u; }
    const size_t kstep = (size_t)(BK * 2);
    const size_t hstepA = (size_t)HALF * lda * 2, hstepB = (size_t)HALF * ldb * 2;
    const unsigned ldsw = (unsigned)wid * 1024u;
    const int aoff = lds_byte(wr * 64 + fr, fq * 8), boff = lds_byte(wc * 32 + fr, fq * 8);
#define PG8_SA(b, h) (((b) * 2 + (h)) * HTB)
#define PG8_SB(b, h) ((4 + (b) * 2 + (h)) * HTB)
#define PG8_STAGE(bufoff, gbase, voff) do { _Pragma("unroll") for (int _i = 0; _i < 2; ++_i) \
        __builtin_amdgcn_global_load_lds((const unsigned*)((const char*)(gbase) + (voff)[_i]), (PG8_LAS unsigned*)(lds + (bufoff) + ldsw + _i * 8192), 16, 0, 0); } while (0)
#define PG8_LDA(dst, b, h) do { _Pragma("unroll") for (int m = 0; m < 4; ++m) _Pragma("unroll") for (int k = 0; k < 2; ++k) dst[m][k] = *(const PG8_LAS bf16x8*)(lds + PG8_SA(b, h) + aoff + m * 2048 + k * 1024); } while (0)
#define PG8_LDB(dst, b, h) do { _Pragma("unroll") for (int n = 0; n < 2; ++n) _Pragma("unroll") for (int k = 0; k < 2; ++k) dst[n][k] = *(const PG8_LAS bf16x8*)(lds + PG8_SB(b, h) + boff + n * 2048 + k * 1024); } while (0)
#define PG8_MMA(ai, bj, At, Bt) do { __builtin_amdgcn_s_setprio(1); _Pragma("unroll") for (int m = 0; m < 4; ++m) _Pragma("unroll") for (int n = 0; n < 2; ++n) _Pragma("unroll") for (int k = 0; k < 2; ++k) \
        acc[ai][bj][m][n] = __builtin_amdgcn_mfma_f32_16x16x32_bf16(Bt[n][k], At[m][k], acc[ai][bj][m][n], 0, 0, 0); __builtin_amdgcn_s_setprio(0); } while (0)
#define PG8_WAIT_V(n) asm volatile("s_waitcnt vmcnt(" #n ")" ::: "memory")
#define PG8_WAIT_L(n) asm volatile("s_waitcnt lgkmcnt(" #n ")" ::: "memory")
#define PG8_BAR __builtin_amdgcn_s_barrier()
#define PG8_SCHED __builtin_amdgcn_sched_barrier(0)
    Unit cur, nxt; int ui = 0;
    if (!S.next(0, cur)) return;
    f32x4 acc[2][2][4][2];
#pragma unroll
    for (int a = 0; a < 2; ++a)
#pragma unroll
        for (int b = 0; b < 2; ++b)
#pragma unroll
            for (int m = 0; m < 4; ++m)
#pragma unroll
                for (int n = 0; n < 2; ++n) acc[a][b][m][n] = (f32x4){0.f, 0.f, 0.f, 0.f};
    constexpr bool HAS_INIT = Epi::ACC_INIT;
    bf16x8 At[4][2], B0[2][2], B1[2][2];
    const char* cA = S.abase(g, cur); const char* cB = S.bbase(g, cur);
    S.a_ready(cur);
    if constexpr (Epi::RSTD) ep_rstd_table(E.ssq, E.rt, cur.pm, tid);
    if constexpr (SP2) {
        PG8_STAGE(PG8_SB(0, 0), cB, voffB); PG8_STAGE(PG8_SB(0, 1), cB + hstepB, voffB); PG8_STAGE(PG8_SA(0, 0), cA, voffA); PG8_STAGE(PG8_SA(0, 1), cA + hstepA, voffA);
        if constexpr (HAS_INIT) E.init(acc, cur, wr, wc, fr, fq);
        if (wr == 1) PG8_BAR;
        PG8_WAIT_V(2); PG8_BAR;
        PG8_STAGE(PG8_SB(1, 0), cB + kstep, voffB); PG8_STAGE(PG8_SA(1, 0), cA + kstep, voffA); PG8_STAGE(PG8_SB(1, 1), cB + hstepB + kstep, voffB);
        PG8_WAIT_V(6); PG8_BAR;
    } else {
        PG8_STAGE(PG8_SB(0, 0), cB, voffB); PG8_STAGE(PG8_SA(0, 0), cA, voffA); PG8_STAGE(PG8_SB(0, 1), cB + hstepB, voffB); PG8_STAGE(PG8_SA(0, 1), cA + hstepA, voffA);
        if (wr == 1) PG8_BAR;
        PG8_WAIT_V(4); PG8_BAR;
        PG8_STAGE(PG8_SB(1, 0), cB + kstep, voffB); PG8_STAGE(PG8_SA(1, 0), cA + kstep, voffA); PG8_STAGE(PG8_SB(1, 1), cB + hstepB + kstep, voffB);
        PG8_WAIT_V(6); PG8_BAR;
    }
    for (;;) {
        const bool has_next = S.next(ui + 1, nxt);
        const char* nA = has_next ? S.abase(g, nxt) : cA; const char* nB = has_next ? S.bbase(g, nxt) : cB;
        for (int t = 0; t < nt; t += 2) {
            const bool last = (t == nt - 2);
            const char* a1 = cA + (size_t)(t + 1) * kstep;
            const char* a2 = last ? nA : cA + (size_t)(t + 2) * kstep; const char* b2 = last ? nB : cB + (size_t)(t + 2) * kstep;
            const char* a3 = a2 + kstep; const char* b3 = b2 + kstep;
            if (last && has_next) S.a_ready(nxt);
            if constexpr (SP2) {
            PG8_LDB(B0, 0, 0); PG8_LDB(B1, 0, 1); PG8_SCHED; PG8_LDA(At, 0, 0); PG8_STAGE(PG8_SA(1, 1), a1 + hstepA, voffA);
            PG8_WAIT_V(8); PG8_WAIT_L(0); PG8_BAR; PG8_MMA(0, 0, At, B0); PG8_MMA(0, 1, At, B1); PG8_BAR; PG8_SCHED;
            PG8_LDA(At, 0, 1); PG8_STAGE(PG8_SB(0, 0), b2, voffB); PG8_STAGE(PG8_SB(0, 1), b2 + hstepB, voffB); PG8_STAGE(PG8_SA(0, 0), a2, voffA);
            PG8_WAIT_V(8); PG8_WAIT_L(0); PG8_BAR; PG8_MMA(1, 0, At, B0); PG8_MMA(1, 1, At, B1); PG8_BAR; PG8_SCHED;
            PG8_LDB(B0, 1, 0); PG8_LDB(B1, 1, 1); PG8_SCHED; PG8_LDA(At, 1, 0); PG8_STAGE(PG8_SA(0, 1), a2 + hstepA, voffA);
            PG8_WAIT_V(8); PG8_WAIT_L(0); PG8_BAR; PG8_MMA(0, 0, At, B0); PG8_MMA(0, 1, At, B1); PG8_BAR; PG8_SCHED;
            PG8_LDA(At, 1, 1); PG8_STAGE(PG8_SB(1, 0), b3, voffB); PG8_STAGE(PG8_SB(1, 1), b3 + hstepB, voffB); PG8_STAGE(PG8_SA(1, 0), a3, voffA);
            PG8_WAIT_V(8); PG8_WAIT_L(0); PG8_BAR; PG8_MMA(1, 0, At, B0); PG8_MMA(1, 1, At, B1); PG8_BAR; PG8_SCHED;
            } else {
            PG8_LDB(B0, 0, 0); PG8_SCHED; PG8_LDA(At, 0, 0); PG8_STAGE(PG8_SA(1, 1), a1 + hstepA, voffA);
            PG8_WAIT_L(8); PG8_BAR; PG8_WAIT_L(0); PG8_MMA(0, 0, At, B0); PG8_BAR; PG8_SCHED;
            PG8_LDB(B1, 0, 1); PG8_STAGE(PG8_SB(0, 0), b2, voffB);
            PG8_BAR; PG8_WAIT_L(0); PG8_MMA(0, 1, At, B1); PG8_BAR;
            PG8_LDA(At, 0, 1); PG8_STAGE(PG8_SA(0, 0), a2, voffA);
            PG8_BAR; PG8_WAIT_L(0); PG8_MMA(1, 0, At, B0); PG8_BAR; PG8_SCHED;
            PG8_STAGE(PG8_SB(0, 1), b2 + hstepB, voffB);
            PG8_WAIT_V(6); PG8_BAR; PG8_MMA(1, 1, At, B1); PG8_BAR;
            PG8_LDB(B0, 1, 0); PG8_SCHED; PG8_LDA(At, 1, 0); PG8_STAGE(PG8_SA(0, 1), a2 + hstepA, voffA);
            PG8_WAIT_L(8); PG8_BAR; PG8_WAIT_L(0); PG8_MMA(0, 0, At, B0); PG8_BAR; PG8_SCHED;
            PG8_LDB(B1, 1, 1); PG8_STAGE(PG8_SB(1, 0), b3, voffB);
            PG8_BAR; PG8_WAIT_L(0); PG8_MMA(0, 1, At, B1); PG8_BAR;
            PG8_LDA(At, 1, 1); PG8_STAGE(PG8_SA(1, 0), a3, voffA);
            PG8_BAR; PG8_WAIT_L(0); PG8_MMA(1, 0, At, B0); PG8_BAR; PG8_SCHED;
            PG8_STAGE(PG8_SB(1, 1), b3 + hstepB, voffB);
            PG8_WAIT_V(6); PG8_BAR; PG8_MMA(1, 1, At, B1); PG8_BAR;
            }
        }
        if constexpr (ALIGN_EPI) { if (wr == 0) PG8_BAR; }
        if constexpr (!Epi::AFTER_DRAIN) { E(acc, cur, wr, wc, fr, fq); S.done(cur); }
        if (!has_next) break;
        if constexpr (Epi::RSTD) { if (nxt.pm != cur.pm) { asm volatile("s_waitcnt lgkmcnt(0)" ::: "memory"); PG8_BAR; int t2_ = tid; asm volatile("" : "+v"(t2_)); ep_rstd_table(E.ssq, E.rt, nxt.pm, t2_); } }
        if constexpr (HAS_INIT) E.init(acc, nxt, wr, wc, fr, fq); else
#pragma unroll
        for (int a = 0; a < 2; ++a)
#pragma unroll
            for (int b = 0; b < 2; ++b)
#pragma unroll
                for (int m = 0; m < 4; ++m)
#pragma unroll
                    for (int n = 0; n < 2; ++n) acc[a][b][m][n] = (f32x4){0.f, 0.f, 0.f, 0.f};
        cur = nxt; cA = nA; cB = nB; ++ui;
        if constexpr (ALIGN_EPI) { if (wr == 1) PG8_BAR; }
    }
    PG8_WAIT_V(0);
    if constexpr (!ALIGN_EPI) { if (wr == 0) PG8_BAR; }
    PG8_BAR;
    if constexpr (Epi::AFTER_DRAIN) { E.fused(acc, cur, wr, wc, fr, fq, lds, wid, lane); S.done(cur); }
#undef PG8_SA
#undef PG8_SB
#undef PG8_STAGE
#undef PG8_LDA
#undef PG8_LDB
#undef PG8_MMA
#undef PG8_WAIT_V
#undef PG8_WAIT_L
#undef PG8_BAR
#undef PG8_SCHED
}
}
namespace cfg {
constexpr int D = 2048, BATCH = 4, SEQ = 2048, DEPTH = 4, DB = 8, DS = 8, NMEM = 256, DFF = 5632, UP = 2 * DFF;
constexpr int MP = BATCH * SEQ, MS = DB * DS, MT = MP + MS, MM = BATCH * NMEM;
constexpr int NQKV = 4608, NINB = 6144;
constexpr float EPS = 1e-6f;
constexpr float LOG2E = 1.4426950408889634f, LN2 = 0.6931471805599453f;
constexpr size_t O_YP = 0;
constexpr size_t O_YS = O_YP + (size_t)BATCH * SEQ * D;
constexpr size_t O_PW0 = O_YS + (size_t)DB * DS * D;
constexpr size_t O_PW1 = O_PW0 + (size_t)2 * BATCH * 128 * 1024;
constexpr size_t O_PW2 = O_PW1 + (size_t)2 * BATCH * 512 * 1024;
constexpr size_t O_PCB = O_PW2 + (size_t)2 * BATCH * 2048 * 1024;
constexpr size_t O_PFC = O_PCB + (size_t)2 * BATCH * 2 * D;
constexpr size_t O_PMK = O_PFC + (size_t)DEPTH * BATCH * 2 * UP;
constexpr size_t O_SW0 = O_PMK + (size_t)DEPTH * BATCH * NMEM * 4096;
constexpr size_t O_SW1 = O_SW0 + (size_t)2 * DB * 128 * 1024;
constexpr size_t O_SW2 = O_SW1 + (size_t)2 * DB * 512 * 1024;
constexpr size_t O_SCB = O_SW2 + (size_t)2 * DB * 2048 * 1024;
constexpr size_t O_SFC = O_SCB + (size_t)2 * DB * 2 * D;
constexpr size_t O_END = O_SFC + (size_t)DEPTH * DB * 2 * UP;
static_assert(O_END == 100925440ull, "output size");
constexpr size_t MiB = 1u << 20;
constexpr size_t WS_CTL = 0, CTL_ZERO_BYTES = 1 * MiB;
constexpr size_t WS_WQKV = 1 * MiB;
constexpr size_t WS_WOA = WS_WQKV + 36 * MiB;
constexpr size_t WS_WINB = WS_WOA + 4 * MiB;
constexpr size_t WS_WOB = WS_WINB + 48 * MiB;
constexpr size_t WS_WQ = WS_WOB + 16 * MiB;
constexpr size_t WS_WKV = WS_WQ + 32 * MiB;
constexpr size_t WS_WO = WS_WKV + 64 * MiB;
constexpr size_t WS_WUP = WS_WO + 32 * MiB;
constexpr size_t WS_WDN = WS_WUP + 176 * MiB;
constexpr size_t WS_Y = WS_WDN + 88 * MiB;
constexpr size_t WS_YB = WS_Y + 65 * MiB;
constexpr size_t WS_SSQ = WS_YB + 33 * MiB;
constexpr size_t WS_SSQS = WS_SSQ + 1 * MiB;
constexpr size_t WS_MEMB = WS_SSQS + 1 * MiB;
constexpr size_t WS_SSQM = WS_MEMB + 4 * MiB;
constexpr size_t WS_KVB = WS_SSQM + 1 * MiB;
constexpr size_t WS_CKV = WS_KVB + 32 * MiB;
constexpr size_t WS_BIG = WS_CKV + 64 * MiB;
constexpr size_t WS_ACT = WS_BIG + 176 * MiB;
constexpr size_t WS_QM = WS_ACT, WS_OM = WS_ACT + 33 * MiB, WS_OG = WS_ACT + 33 * MiB, WS_LSE = WS_ACT + 58 * MiB, WS_MRG = WS_ACT + 66 * MiB;
constexpr size_t WS_SMALL = WS_ACT + 99 * MiB;
constexpr size_t WS_QKVS = WS_SMALL, WS_U3S = WS_SMALL + 2 * MiB, WS_US = WS_SMALL + 4 * MiB;
constexpr size_t WS_HALO = WS_SMALL + 8 * MiB;
constexpr size_t WS_WQNT = WS_HALO + 8 * MiB;
constexpr size_t WS_MKT = WS_WQNT + 32 * MiB;
constexpr size_t WS_VWT = WS_MKT + 32 * MiB;
constexpr size_t WS_END = WS_VWT + 32 * MiB;
static_assert((size_t)MT * 5632 * 2 <= 99 * MiB && (size_t)3 * MT * 512 * 2 <= 25 * MiB && (size_t)MT * 2048 * 2 <= 33 * MiB, "ws map");
}

namespace ep {
using pg8::f32x4; using pg8::u32x4; using pg8::bf16_t; using pg8::Unit; using pg8::cvt_pk_bf16; using pg8::HALF; using pg8::BM;
__device__ __forceinline__ float row_rstd(const float* ssq, int row, int fq) {
    const f32x4* p = (const f32x4*)(ssq + (size_t)row * 32 + fq * 8);
    const f32x4 a = p[0], b = p[1];
    float s = ((a[0] + a[1]) + (a[2] + a[3])) + ((b[0] + b[1]) + (b[2] + b[3]));
    s += __shfl_xor(s, 16); s += __shfl_xor(s, 32);
    return 1.0f / sqrtf(s * (1.0f / 2048.0f) + cfg::EPS);
}
__device__ __forceinline__ void rstd_table(const float* ssq, PG8_LAS float* rt, int pm, int tid) {
    const int row = tid >> 1, hf = tid & 1; const f32x4* p = (const f32x4*)(ssq + (size_t)(pm * BM + row) * 32 + hf * 16);
    const f32x4 a = p[0], b = p[1], c = p[2], d = p[3];
    float s = (((a[0] + a[1]) + (a[2] + a[3])) + ((b[0] + b[1]) + (b[2] + b[3]))) + (((c[0] + c[1]) + (c[2] + c[3])) + ((d[0] + d[1]) + (d[2] + d[3])));
    s += __shfl_xor(s, 1);
    if (hf == 0) rt[row] = 1.0f / sqrtf(s * (1.0f / 2048.0f) + cfg::EPS);
}
__device__ __forceinline__ float rs_lookup(const float* ssq, const PG8_LAS float* rt, int pm, int rit, int fq) { (void)ssq; (void)pm; (void)fq; return rt[rit]; }
__device__ __forceinline__ u32x4 pack8(const f32x4 v0, const f32x4 v1) { u32x4 w; w.x = cvt_pk_bf16(v0[0], v0[1]); w.y = cvt_pk_bf16(v0[2], v0[3]); w.z = cvt_pk_bf16(v1[0], v1[1]); w.w = cvt_pk_bf16(v1[2], v1[3]); return w; }

struct EpiScale {
    static constexpr bool PERM = true, AFTER_DRAIN = false, ACC_INIT = false, RSTD = true;
    bf16_t* O; int ldc; const float* ssq; float scale; PG8_LAS float* rt;
    __device__ __forceinline__ void operator()(const f32x4 (&acc)[2][2][4][2], const Unit& u, int wr, int wc, int fr, int fq) const {
        const int col0 = u.pn * BM + wc * 32 + 8 * fq;
#pragma unroll
        for (int ai = 0; ai < 2; ++ai)
#pragma unroll
            for (int m = 0; m < 4; ++m) { const int rit = ai * HALF + wr * 64 + m * 16 + fr, row = u.pm * BM + rit; const float rs = rs_lookup(ssq, rt, u.pm, rit, fq) * scale;
                bf16_t* rowp = O + (size_t)row * ldc + col0;
#pragma unroll
                for (int bj = 0; bj < 2; ++bj) *(u32x4*)(rowp + bj * HALF) = pack8(acc[ai][bj][m][0] * rs, acc[ai][bj][m][1] * rs); }
    }
};
struct EpiQKV {
    static constexpr bool PERM = true, AFTER_DRAIN = false, ACC_INIT = false, RSTD = true;
    bf16_t* O; const float* ssq; float* out; int j; float qscale; PG8_LAS float* rt;
    __device__ __forceinline__ void operator()(const f32x4 (&acc)[2][2][4][2], const Unit& u, int wr, int wc, int fr, int fq) const {
        const int colt = u.pn * BM; const int g = colt / 1536, rem = colt - g * 1536, w = rem / 512, c512 = rem - w * 512;
        const float sc = (w == 0) ? qscale : 1.f;
        const int nb = u.pm >> 3, t0 = (u.pm & 7) * BM;
        const int keep = (g == 0) ? 128 : (g == 1 ? 512 : 2048);
        float* pw = out + (g == 0 ? cfg::O_PW0 : (g == 1 ? cfg::O_PW1 : cfg::O_PW2));
        const int col0 = colt + wc * 32 + 8 * fq;
#pragma unroll
        for (int ai = 0; ai < 2; ++ai)
#pragma unroll
            for (int m = 0; m < 4; ++m) { const int rit = ai * HALF + wr * 64 + m * 16 + fr, row = u.pm * BM + rit, t = t0 + rit; const float r0 = rs_lookup(ssq, rt, u.pm, rit, fq), rs = r0 * sc;
                bf16_t* rowp = O + (size_t)row * cfg::NQKV + col0;
#pragma unroll
                for (int bj = 0; bj < 2; ++bj) *(u32x4*)(rowp + bj * HALF) = pack8(acc[ai][bj][m][0] * rs, acc[ai][bj][m][1] * rs);
                if (w >= 1 && t >= 2048 - keep) {
                    float* d = pw + ((((size_t)(j * 4 + nb) * keep + (t - (2048 - keep))) * 2 + (w - 1)) * 512) + c512 + wc * 32 + 8 * fq;
#pragma unroll
                    for (int bj = 0; bj < 2; ++bj) { __builtin_nontemporal_store(acc[ai][bj][m][0] * r0, (f32x4*)(d + bj * HALF)); __builtin_nontemporal_store(acc[ai][bj][m][1] * r0, (f32x4*)(d + bj * HALF + 4)); }
                } }
    }
};
__device__ __forceinline__ float dpp_ror1(float x) { return __builtin_bit_cast(float, __builtin_amdgcn_mov_dpp(__builtin_bit_cast(int, x), 0x121, 0xF, 0xF, true)); }
__device__ __forceinline__ float dpp_ror2(float x) { return __builtin_bit_cast(float, __builtin_amdgcn_mov_dpp(__builtin_bit_cast(int, x), 0x122, 0xF, 0xF, true)); }
struct EpiUpConv {
    static constexpr bool PERM = true, AFTER_DRAIN = false, ACC_INIT = false, RSTD = true;
    bf16_t* ACT; const float* ssq; float* out; float* halog; const float* cw; int layer; PG8_LAS float* hl; PG8_LAS float* rt;
    __device__ __forceinline__ void operator()(f32x4 (&acc)[2][2][4][2], const Unit& u, int wr, int wc, int fr, int fq) const {
        asm volatile("" : "+v"(fr), "+v"(fq));
        const int q = u.pn, nb = u.pm >> 3; const int lc = wc * 32 + 8 * fq;
#pragma unroll
        for (int ai = 0; ai < 2; ++ai)
#pragma unroll
            for (int m = 0; m < 4; ++m) { const int rit = ai * HALF + wr * 64 + m * 16 + fr; const float rs = rs_lookup(ssq, rt, u.pm, rit, fq);
#pragma unroll
                for (int bj = 0; bj < 2; ++bj)
#pragma unroll
                    for (int n = 0; n < 2; ++n) acc[ai][bj][m][n] = acc[ai][bj][m][n] * rs;
                if (m == 3 && fr >= 14) {
#pragma unroll
                    for (int bj = 0; bj < 2; ++bj)
#pragma unroll
                        for (int n = 0; n < 2; ++n) *(PG8_LAS f32x4*)(hl + (((ai * 2 + wr) * 2 + (fr - 14)) * 256 + bj * HALF + lc + 4 * n)) = acc[ai][bj][m][n]; }
                if ((ai == 0 && m == 0) || (ai == 1 && m == 3)) { if (rit < 2 || rit >= 254) { const int slot = rit < 2 ? rit : rit - 252;
                    float* hg = halog + ((size_t)(u.pm * 4 + slot) * cfg::UP) + q * 256 + lc;
#pragma unroll
                    for (int bj = 0; bj < 2; ++bj)
#pragma unroll
                        for (int n = 0; n < 2; ++n) *(f32x4*)(hg + bj * HALF + 4 * n) = acc[ai][bj][m][n];
                    if (rit >= 254 && (u.pm & 7) == 7) { float* d = out + cfg::O_PFC + ((size_t)(layer * 4 + nb) * 2 + (rit - 254)) * cfg::UP + q * 128 + lc;
#pragma unroll
                        for (int n = 0; n < 2; ++n) { *(f32x4*)(d + 4 * n) = acc[ai][0][m][n]; *(f32x4*)(d + cfg::DFF + 4 * n) = acc[ai][1][m][n]; } } } }
            }
        asm volatile("s_waitcnt lgkmcnt(0)" ::: "memory"); __builtin_amdgcn_s_barrier(); asm volatile("" ::: "memory");
#pragma unroll
        for (int n = 0; n < 2; ++n) { const float* wp = cw + q * 128 + lc + 4 * n;
            const f32x4 wa0 = *(const f32x4*)wp, wa1 = *(const f32x4*)(wp + cfg::UP), wa2 = *(const f32x4*)(wp + 2 * cfg::UP);
            const f32x4 wb0 = *(const f32x4*)(wp + cfg::DFF), wb1 = *(const f32x4*)(wp + cfg::UP + cfg::DFF), wb2 = *(const f32x4*)(wp + 2 * cfg::UP + cfg::DFF);
#pragma unroll
            for (int ai = 0; ai < 2; ++ai) {
                f32x4 pa = (f32x4){0.f, 0.f, 0.f, 0.f}, pb = (f32x4){0.f, 0.f, 0.f, 0.f};
                if (ai == 1 || wr == 1) { const int sai = (wr == 1) ? ai : ai - 1, swr = (wr == 1) ? 0 : 1;
                    const PG8_LAS float* hp = hl + (((sai * 2 + swr) * 2 + (fr >= 14 ? fr - 14 : 0)) * 256 + lc + 4 * n);
                    pa = *(const PG8_LAS f32x4*)hp; pb = *(const PG8_LAS f32x4*)(hp + HALF); }
#pragma unroll
                for (int m = 0; m < 4; ++m) { const f32x4 ca = acc[ai][0][m][n], cb = acc[ai][1][m][n]; f32x4 o;
#pragma unroll
                    for (int i = 0; i < 4; ++i) {
                        const float a1 = dpp_ror1(fr == 15 ? pa[i] : ca[i]), a2 = dpp_ror2(fr >= 14 ? pa[i] : ca[i]);
                        const float b1 = dpp_ror1(fr == 15 ? pb[i] : cb[i]), b2 = dpp_ror2(fr >= 14 ? pb[i] : cb[i]);
                        const float va = wa0[i] * a2 + wa1[i] * a1 + wa2[i] * ca[i], vb = wb0[i] * b2 + wb1[i] * b1 + wb2[i] * cb[i];
                        o[i] = va * __builtin_amdgcn_rcpf(1.0f + __expf(-va)) * vb; }
                    const int row = u.pm * BM + ai * HALF + wr * 64 + m * 16 + fr;
                    typedef unsigned u32x2e __attribute__((ext_vector_type(2)));
                    u32x2e w; w.x = cvt_pk_bf16(o[0], o[1]); w.y = cvt_pk_bf16(o[2], o[3]);
                    *(u32x2e*)(ACT + (size_t)row * cfg::DFF + q * 128 + lc + 4 * n) = w;
                    pa = ca; pb = cb; }
            } }
    }
};
struct EpiKV {
    static constexpr bool PERM = true, AFTER_DRAIN = false, ACC_INIT = false, RSTD = true;
    bf16_t* O; const float* ssq; float* out; PG8_LAS float* rt;
    __device__ __forceinline__ void operator()(const f32x4 (&acc)[2][2][4][2], const Unit& u, int wr, int wc, int fr, int fq) const {
        const int layer = u.pn >> 4, col0 = (u.pn & 15) * BM + wc * 32 + 8 * fq;
#pragma unroll
        for (int ai = 0; ai < 2; ++ai)
#pragma unroll
            for (int m = 0; m < 4; ++m) { const int rit = ai * HALF + wr * 64 + m * 16 + fr, row = u.pm * BM + rit; const float rs = rs_lookup(ssq, rt, u.pm, rit, fq);
                const size_t off = ((size_t)layer * cfg::MM + row) * 4096 + col0;
#pragma unroll
                for (int bj = 0; bj < 2; ++bj) { const f32x4 v0 = acc[ai][bj][m][0] * rs, v1 = acc[ai][bj][m][1] * rs;
                    *(u32x4*)(O + off + bj * HALF) = pack8(v0, v1); __builtin_nontemporal_store(v0, (f32x4*)(out + cfg::O_PMK + off + bj * HALF)); __builtin_nontemporal_store(v1, (f32x4*)(out + cfg::O_PMK + off + bj * HALF + 4)); } }
    }
};
struct EpiResid {
    static constexpr bool PERM = true, AFTER_DRAIN = false, ACC_INIT = true, RSTD = false;
    bf16_t* YB; float* ssq;
    __device__ __forceinline__ void init(f32x4 (&acc)[2][2][4][2], const Unit& u, int wr, int wc, int fr, int fq) const {
        const int col0 = u.pn * BM + wc * 32 + 8 * fq;
        u32x4 raw[2][2][4];
#pragma unroll
        for (int ai = 0; ai < 2; ++ai)
#pragma unroll
            for (int m = 0; m < 4; ++m) { const size_t off = (size_t)(u.pm * BM + ai * HALF + wr * 64 + m * 16 + fr) * 2048 + col0;
#pragma unroll
                for (int bj = 0; bj < 2; ++bj) raw[ai][bj][m] = *(const u32x4*)(YB + off + bj * HALF); }
#pragma unroll
        for (int ai = 0; ai < 2; ++ai)
#pragma unroll
            for (int m = 0; m < 4; ++m)
#pragma unroll
                for (int bj = 0; bj < 2; ++bj) { const u32x4 yb = raw[ai][bj][m];
                    acc[ai][bj][m][0] = (f32x4){__uint_as_float(yb.x << 16), __uint_as_float(yb.x & 0xffff0000u), __uint_as_float(yb.y << 16), __uint_as_float(yb.y & 0xffff0000u)};
                    acc[ai][bj][m][1] = (f32x4){__uint_as_float(yb.z << 16), __uint_as_float(yb.z & 0xffff0000u), __uint_as_float(yb.w << 16), __uint_as_float(yb.w & 0xffff0000u)}; }
    }
    __device__ __forceinline__ void operator()(const f32x4 (&acc)[2][2][4][2], const Unit& u, int wr, int wc, int fr, int fq) const {
        const int col0 = u.pn * BM + wc * 32 + 8 * fq;
#pragma unroll
        for (int ai = 0; ai < 2; ++ai)
#pragma unroll
            for (int m = 0; m < 4; ++m) { const int row = u.pm * BM + ai * HALF + wr * 64 + m * 16 + fr; const size_t off = (size_t)row * 2048 + col0; float part = 0.f;
#pragma unroll
                for (int bj = 0; bj < 2; ++bj) { const f32x4 y0 = acc[ai][bj][m][0], y1 = acc[ai][bj][m][1];
                    *(u32x4*)(YB + off + bj * HALF) = pack8(y0, y1);
                    part += ((y0[0] * y0[0] + y0[1] * y0[1]) + (y0[2] * y0[2] + y0[3] * y0[3])) + ((y1[0] * y1[0] + y1[1] * y1[1]) + (y1[2] * y1[2] + y1[3] * y1[3])); }
                part += __shfl_xor(part, 16); part += __shfl_xor(part, 32);
                if (fq == 0) ssq[(size_t)row * 32 + u.pn * 4 + wc] = part; }
    }
};
struct PrepOrder {
    int mode, w, nw; const bf16_t* KVl; const bf16_t* Wl;
    __device__ __forceinline__ bool next(int i, Unit& u) const { const int q = w + i * nw; if (w < 0 || q >= 128) return false; u.z = q >> 3; const int jj = q & 7; u.pm = mode ? jj : 0; u.pn = mode ? 0 : jj; return true; }
    __device__ __forceinline__ void a_ready(const Unit&) const {}
    __device__ __forceinline__ void done(const Unit&) const {}
    __device__ __forceinline__ const char* abase(const pg8::Gemm&, const Unit& u) const { const int n = u.z >> 2, h = u.z & 3;
        return mode ? (const char*)(Wl + (size_t)(256 * u.pm) * 2048 + h * 512) : (const char*)(KVl + (size_t)(n * 256) * 4096 + h * 512); }
    __device__ __forceinline__ const char* bbase(const pg8::Gemm&, const Unit& u) const { const int n = u.z >> 2, h = u.z & 3;
        return mode ? (const char*)(KVl + (size_t)(n * 256) * 4096 + 2048 + h * 512) : (const char*)(Wl + (size_t)(256 * u.pn) * 2048 + h * 512); }
};
struct EpiPrep {
    static constexpr bool PERM = true, AFTER_DRAIN = false, ACC_INIT = false, RSTD = false;
    bf16_t* O; int ldc; float scale; size_t zn, zh;
    __device__ __forceinline__ void operator()(const f32x4 (&acc)[2][2][4][2], const Unit& u, int wr, int wc, int fr, int fq) const {
        bf16_t* base = O + (size_t)(u.z >> 2) * zn + (size_t)(u.z & 3) * zh; const int col0 = u.pn * BM + wc * 32 + 8 * fq;
#pragma unroll
        for (int ai = 0; ai < 2; ++ai)
#pragma unroll
            for (int m = 0; m < 4; ++m) { const int row = u.pm * BM + ai * HALF + wr * 64 + m * 16 + fr; bf16_t* rowp = base + (size_t)row * ldc + col0;
#pragma unroll
                for (int bj = 0; bj < 2; ++bj) *(u32x4*)(rowp + bj * HALF) = pack8(acc[ai][bj][m][0] * scale, acc[ai][bj][m][1] * scale); }
    }
};
struct ScoreOrder : pg8::StaticOrder {
    const bf16_t* MK;
    __device__ __forceinline__ const char* bbase(const pg8::Gemm&, const Unit& u) const { return (const char*)(MK + ((size_t)(u.pm >> 3) * 1024 + 256 * u.pn) * 2048); }
};
struct OutOrder : pg8::StaticOrder {
    const bf16_t* VW;
    __device__ __forceinline__ const char* bbase(const pg8::Gemm&, const Unit& u) const { return (const char*)(VW + ((size_t)(u.pm >> 3) * 2048 + 256 * u.pn) * 1024); }
};
struct EpiSoftmax {
    static constexpr bool PERM = true, AFTER_DRAIN = true, ACC_INIT = false, RSTD = true;
    bf16_t* P; const float* ssq; PG8_LAS float* rt;
    __device__ __forceinline__ void fused(f32x4 (&acc)[2][2][4][2], const Unit& u, int wr, int wc, int fr, int fq, PG8_LAS unsigned char* lds, int wid, int lane) const {
        PG8_LAS float* Pm = (PG8_LAS float*)lds; PG8_LAS float* Ps = (PG8_LAS float*)(lds + 4096);
        float mx[2][4];
#pragma unroll
        for (int ai = 0; ai < 2; ++ai)
#pragma unroll
            for (int m = 0; m < 4; ++m) { const int rit = ai * HALF + wr * 64 + m * 16 + fr; const float rs = rs_lookup(ssq, rt, u.pm, rit, fq); float v = -3.0e38f;
#pragma unroll
                for (int bj = 0; bj < 2; ++bj)
#pragma unroll
                    for (int n = 0; n < 2; ++n) { f32x4 s = acc[ai][bj][m][n] * rs; acc[ai][bj][m][n] = s; v = fmaxf(v, fmaxf(fmaxf(s[0], s[1]), fmaxf(s[2], s[3]))); }
                v = fmaxf(v, __shfl_xor(v, 16)); v = fmaxf(v, __shfl_xor(v, 32)); mx[ai][m] = v;
                if (fq == 0) Pm[rit * 4 + wc] = v; }
        asm volatile("s_waitcnt lgkmcnt(0)" ::: "memory"); __builtin_amdgcn_s_barrier(); asm volatile("" ::: "memory");
#pragma unroll
        for (int ai = 0; ai < 2; ++ai)
#pragma unroll
            for (int m = 0; m < 4; ++m) { const int rit = ai * HALF + wr * 64 + m * 16 + fr; const f32x4 pm4 = *(const PG8_LAS f32x4*)(Pm + rit * 4);
                const float M = fmaxf(fmaxf(pm4[0], pm4[1]), fmaxf(pm4[2], pm4[3])); float sum = 0.f;
#pragma unroll
                for (int bj = 0; bj < 2; ++bj)
#pragma unroll
                    for (int n = 0; n < 2; ++n) { f32x4 s = acc[ai][bj][m][n]; s[0] = exp2f(s[0] - M); s[1] = exp2f(s[1] - M); s[2] = exp2f(s[2] - M); s[3] = exp2f(s[3] - M); acc[ai][bj][m][n] = s; sum += (s[0] + s[1]) + (s[2] + s[3]); }
                sum += __shfl_xor(sum, 16); sum += __shfl_xor(sum, 32);
                if (fq == 0) Ps[rit * 4 + wc] = sum; }
        asm volatile("s_waitcnt lgkmcnt(0)" ::: "memory"); __builtin_amdgcn_s_barrier(); asm volatile("" ::: "memory");
        const int col0 = u.pn * BM + wc * 32 + 8 * fq;
#pragma unroll
        for (int ai = 0; ai < 2; ++ai)
#pragma unroll
            for (int m = 0; m < 4; ++m) { const int rit = ai * HALF + wr * 64 + m * 16 + fr; const f32x4 ps4 = *(const PG8_LAS f32x4*)(Ps + rit * 4);
                const float inv = 1.0f / ((ps4[0] + ps4[1]) + (ps4[2] + ps4[3])); bf16_t* rowp = P + (size_t)(u.pm * BM + rit) * 1024 + col0;
#pragma unroll
                for (int bj = 0; bj < 2; ++bj) *(u32x4*)(rowp + bj * HALF) = pack8(acc[ai][bj][m][0] * inv, acc[ai][bj][m][1] * inv); }
        (void)mx; (void)wid; (void)lane;
    }
};
}
namespace pg8 { __device__ __forceinline__ void ep_rstd_table(const float* ssq, PG8_LAS float* rt, int pm, int tid) { ep::rstd_table(ssq, rt, pm, tid); } }
#define GAS __attribute__((address_space(1)))
#define LAS __attribute__((address_space(3)))
typedef unsigned short bf16;
typedef unsigned v4u __attribute__((ext_vector_type(4)));
typedef float f32x4 __attribute__((ext_vector_type(4)));
typedef short bf16x8 __attribute__((ext_vector_type(8)));
typedef GAS unsigned gu32;
typedef GAS unsigned long long gu64;
#define RLX_AGENT __ATOMIC_RELAXED, __HIP_MEMORY_SCOPE_AGENT
#define LDS_WAIT() asm volatile("s_waitcnt lgkmcnt(0)" ::: "memory")
#define VM_WAIT() asm volatile("s_waitcnt vmcnt(0)" ::: "memory")
__device__ __forceinline__ unsigned long long rt() { return __builtin_amdgcn_s_memrealtime(); }
__device__ __forceinline__ unsigned f2bf(float f) { unsigned u = __builtin_bit_cast(unsigned, f); return (u + 0x7fffu + ((u >> 16) & 1u)) >> 16; }
__device__ __forceinline__ unsigned pk2(float lo, float hi) { return f2bf(lo) | (f2bf(hi) << 16); }

#define XB_TMO      128
#define XB_XCNT(j)  (256  + 64 * (j))
#define XB_XSUB(j)  (1280 + 64 * (j))
#define XB_XGEN(j)  (2304 + 64 * (j))
#define XB_TOP      3328
#define XB_TOPGEN   3392
#define XCD_BAR_WORDS 3456
#define XB_SPIN_CAP (1u << 18)

__device__ __forceinline__ unsigned xb_ld(unsigned* p)              { return __hip_atomic_load(p, __ATOMIC_RELAXED, __HIP_MEMORY_SCOPE_AGENT); }
__device__ __forceinline__ unsigned xb_add(unsigned* p, unsigned v) { return __hip_atomic_fetch_add(p, v, __ATOMIC_RELAXED, __HIP_MEMORY_SCOPE_AGENT); }
__device__ __forceinline__ unsigned xb_xcc_id() { return (unsigned)__builtin_amdgcn_s_getreg((3 << 11) | 20) & 0xFu; }
#define XB_SPIN(cond, bar) do { unsigned _sp = 0; while (cond) { __builtin_amdgcn_s_sleep(1); \
    if ((++_sp & 255u) == 0u) { if (xb_ld(&(bar)[XB_TMO])) break; if (_sp > XB_SPIN_CAP) { atomicAdd(&(bar)[XB_TMO], 1u); break; } } } } while (0)

struct XcdBarrier {
    unsigned* bar; unsigned x;
    volatile LAS unsigned* st;
};

__device__ __forceinline__ XcdBarrier xcd_barrier_post(unsigned* bar, volatile LAS unsigned* st) {
    XcdBarrier b; b.bar = bar; b.x = xb_xcc_id(); b.st = st;
    if (threadIdx.x == 0) (void)xb_add(&bar[XB_XCNT(b.x)], 1u);
    return b;
}
__device__ __forceinline__ void xcd_barrier_complete(unsigned* bar, unsigned x, unsigned& nloc, unsigned& nx) {
    const unsigned G = gridDim.x * gridDim.y * gridDim.z;
    unsigned sum, cnt, mine, sp = 0u;
    for (;;) {
        sum = 0u; cnt = 0u; mine = 0u;
#pragma unroll
        for (unsigned j = 0; j < 16; ++j) { const unsigned c = xb_ld(&bar[XB_XCNT(j)]); sum += c; cnt += (c > 0u) ? 1u : 0u; mine = (j == x) ? c : mine; }
        if (sum == G) break;
        __builtin_amdgcn_s_sleep(1);
        if ((++sp & 255u) == 0u) { if (xb_ld(&bar[XB_TMO])) break; if (sp > XB_SPIN_CAP) { atomicAdd(&bar[XB_TMO], 1u); break; } }
    }
    nloc = mine > 0u ? mine : 1u; nx = cnt > 0u ? cnt : 1u;
}

__device__ __forceinline__ void xcd_barrier(const XcdBarrier& b) {
    asm volatile("s_waitcnt vmcnt(0)" ::: "memory");
    __syncthreads();
    if (threadIdx.x == 0) {
        unsigned* bar = b.bar;
        __builtin_amdgcn_s_waitcnt(0);
        unsigned nloc = b.st[0], nx = b.st[1];
        if (nloc == 0u) { xcd_barrier_complete(bar, b.x, nloc, nx); b.st[0] = nloc; b.st[1] = nx; }
        const unsigned old = xb_add(&bar[XB_XSUB(b.x)], 1u);
        const unsigned gen = old / nloc;
        if (old + 1u == (gen + 1u) * nloc) {
            __builtin_amdgcn_fence(__ATOMIC_RELEASE, "agent");
            asm volatile("s_waitcnt vmcnt(0)" ::: "memory");
            const unsigned og = xb_add(&bar[XB_TOP], 1u);
            const unsigned tg = og / nx;
            if (og + 1u == (tg + 1u) * nx) xb_add(&bar[XB_TOPGEN], 1u);
            else XB_SPIN(xb_ld(&bar[XB_TOPGEN]) == tg, bar);
            __builtin_amdgcn_fence(__ATOMIC_ACQUIRE, "agent");
            xb_add(&bar[XB_XGEN(b.x)], 1u);
            asm volatile("s_waitcnt vmcnt(0)" ::: "memory");
        } else {
            XB_SPIN(xb_ld(&bar[XB_XGEN(b.x)]) == gen, bar);
            __builtin_amdgcn_fence(__ATOMIC_ACQUIRE, "agent");
            asm volatile("s_waitcnt vmcnt(0)" ::: "memory");
        }
    }
    __syncthreads();
}
#ifndef PROBE_SMODE
#define PROBE_SMODE 0
#endif
#ifndef PROBE_MASK
#define PROBE_MASK 0
#endif
struct Args { const float* in[25]; float* out; unsigned char* ws; int ph_lo, ph_hi; };
typedef const __attribute__((address_space(4))) Args* KArgs;

constexpr int NWAVES = 8, NTHREADS = 512;
constexpr int RING_BYTES = 131072;
constexpr int SCR_BYTES = 155648;
constexpr int MISC_OFF = SCR_BYTES;
constexpr int LDS_BYTES = SCR_BYTES + 256;
typedef unsigned u32x4g __attribute__((ext_vector_type(4)));
typedef unsigned u32x2g __attribute__((ext_vector_type(2)));
typedef float f32x2g __attribute__((ext_vector_type(2)));
typedef short s16x4g __attribute__((ext_vector_type(4)));

__device__ __forceinline__ unsigned cvtpk(float lo, float hi) { unsigned r; asm volatile("v_cvt_pk_bf16_f32 %0, %1, %2" : "=v"(r) : "v"(lo), "v"(hi)); return r; }
__device__ __forceinline__ float bf_lo(unsigned w) { return __uint_as_float(w << 16); }
__device__ __forceinline__ float bf_hi(unsigned w) { return __uint_as_float(w & 0xffff0000u); }
__device__ __forceinline__ float wave_sum(float v) {
#pragma unroll
    for (int o = 1; o < 64; o <<= 1) v += __shfl_xor(v, o);
    return v;
}
__device__ __forceinline__ float wave_max(float v) {
#pragma unroll
    for (int o = 1; o < 64; o <<= 1) v = fmaxf(v, __shfl_xor(v, o));
    return v;
}
__device__ __forceinline__ f32x4 mfma16(bf16x8 a, bf16x8 b, f32x4 c) { return __builtin_amdgcn_mfma_f32_16x16x32_bf16(a, b, c, 0, 0, 0); }
__device__ __forceinline__ s16x4g ldtr(const LAS unsigned char* p) { return __builtin_bit_cast(s16x4g, __builtin_amdgcn_ds_read_tr16_b64_v4i16((LAS s16x4g*)p)); }

__device__ __forceinline__ void unpack8(float (&d)[8], const u32x4g v) { d[0] = bf_lo(v.x); d[1] = bf_hi(v.x); d[2] = bf_lo(v.y); d[3] = bf_hi(v.y); d[4] = bf_lo(v.z); d[5] = bf_hi(v.z); d[6] = bf_lo(v.w); d[7] = bf_hi(v.w); }
__device__ __forceinline__ int up_perm_row(int n) { return n < cfg::DFF ? 256 * (n >> 7) + (n & 127) : 256 * ((n - cfg::DFF) >> 7) + 128 + ((n - cfg::DFF) & 127); }
template <bool UPPERM>
__device__ __forceinline__ void p0_transpose_item2(const float* W, const float* gain, int K, int N, bf16* WT, LAS float* scr, int item0, int item1, int lane) {
    const int nblk = N / 32; const int kr = lane >> 3, nc = (lane & 7) * 4, c = lane & 7;
    const bool two = item1 >= 0; const int it1 = two ? item1 : item0;
    const int k0a = 64 * (item0 / nblk), n0a = 32 * (item0 % nblk), k0b = 64 * (it1 / nblk), n0b = 32 * (it1 % nblk);
    f32x4 va[8], vb[8];
#pragma unroll
    for (int i = 0; i < 8; ++i) va[i] = __builtin_nontemporal_load((const GAS f32x4*)(W + (size_t)(k0a + kr + 8 * i) * N + n0a + nc));
#pragma unroll
    for (int i = 0; i < 8; ++i) vb[i] = __builtin_nontemporal_load((const GAS f32x4*)(W + (size_t)(k0b + kr + 8 * i) * N + n0b + nc));
    LAS float* scb = scr + 64 * 33;
#pragma unroll
    for (int i = 0; i < 8; ++i) { const float g = gain ? gain[k0a + kr + 8 * i] : 1.0f; LAS float* d = scr + (kr + 8 * i) * 33 + nc; d[0] = va[i].x * g; d[1] = va[i].y * g; d[2] = va[i].z * g; d[3] = va[i].w * g; }
#pragma unroll
    for (int i = 0; i < 8; ++i) { const float g = gain ? gain[k0b + kr + 8 * i] : 1.0f; LAS float* d = scb + (kr + 8 * i) * 33 + nc; d[0] = vb[i].x * g; d[1] = vb[i].y * g; d[2] = vb[i].z * g; d[3] = vb[i].w * g; }
    LDS_WAIT(); asm volatile("" ::: "memory");
#pragma unroll
    for (int jj = 0; jj < 4; ++jj) { const int n = (lane >> 3) + 8 * jj; const LAS float* s = scr + (8 * c) * 33 + n;
        v4u o; o.x = pk2(s[0 * 33], s[1 * 33]); o.y = pk2(s[2 * 33], s[3 * 33]); o.z = pk2(s[4 * 33], s[5 * 33]); o.w = pk2(s[6 * 33], s[7 * 33]);
        *(GAS v4u*)(WT + (size_t)((UPPERM ? up_perm_row(n0a) : n0a) + n) * K + k0a + 8 * c) = o; }
    if (two) {
#pragma unroll
        for (int jj = 0; jj < 4; ++jj) { const int n = (lane >> 3) + 8 * jj; const LAS float* s = scb + (8 * c) * 33 + n;
            v4u o; o.x = pk2(s[0 * 33], s[1 * 33]); o.y = pk2(s[2 * 33], s[3 * 33]); o.z = pk2(s[4 * 33], s[5 * 33]); o.w = pk2(s[6 * 33], s[7 * 33]);
            *(GAS v4u*)(WT + (size_t)((UPPERM ? up_perm_row(n0b) : n0b) + n) * K + k0b + 8 * c) = o; } }
    LDS_WAIT(); asm volatile("" ::: "memory");
}
__device__ __forceinline__ void p0_row(const float* xrow, float* yrow, bf16* ybrow, float* ssqrow, int nslots, int lane) {
    const GAS f32x4* xr = (const GAS f32x4*)xrow + lane;
    f32x4 v[8]; float s = 0.f;
#pragma unroll
    for (int q = 0; q < 8; ++q) { v[q] = xr[64 * q]; s += (v[q].x * v[q].x + v[q].y * v[q].y) + (v[q].z * v[q].z + v[q].w * v[q].w); }
    s = wave_sum(s);
    if (yrow) { GAS f32x4* yr = (GAS f32x4*)yrow + lane;
#pragma unroll
        for (int q = 0; q < 8; ++q) yr[64 * q] = v[q]; }
    GAS u32x2g* o8 = (GAS u32x2g*)ybrow + lane;
#pragma unroll
    for (int q = 0; q < 8; ++q) { u32x2g w; w.x = cvtpk(v[q].x, v[q].y); w.y = cvtpk(v[q].z, v[q].w); o8[64 * q] = w; }
    for (int q = lane; q < nslots; q += 64) ssqrow[q] = (q == 0) ? s : 0.f;
}

template <int type>
__device__ __forceinline__ void run_job(int layer, int plo, int phi, int widx, int nw, KArgs args, unsigned char* ws, float* out, LAS float* scr, int lane) {
    if constexpr (type <= 8) {
        int K = 2048, N = 2048; const float* W; const float* gain = nullptr; size_t wso;
        switch (type) {
            case 0: N = 4608; W = args->in[14]; gain = args->in[9] + (2 * layer) * 2048; wso = cfg::WS_WQKV; break;
            case 1: K = 512; W = args->in[15]; wso = cfg::WS_WOA; break;
            case 2: N = 6144; W = args->in[16]; gain = args->in[9] + (2 * layer + 1) * 2048; wso = cfg::WS_WINB; break;
            case 3: W = args->in[18]; wso = cfg::WS_WOB; break;
            case 4: W = args->in[19]; gain = args->in[10] + layer * 2048; wso = cfg::WS_WQ; break;
            case 5: N = 4096; W = args->in[20]; gain = args->in[11] + layer * 2048; wso = cfg::WS_WKV; break;
            case 6: W = args->in[21]; wso = cfg::WS_WO; break;
            case 7: N = 11264; W = args->in[22]; gain = args->in[12] + layer * 2048; wso = cfg::WS_WUP; break;
            default: K = 5632; W = args->in[24]; wso = cfg::WS_WDN; break;
        }
        W += (size_t)layer * K * N;
        bf16* WT = (bf16*)(ws + wso) + (size_t)layer * K * N;
        const int n = (K / 64) * (N / 32), lo = (int)((long)n * plo / 6), hi = (int)((long)n * phi / 6);
        for (int it = lo + widx; it < hi; it += 2 * nw) p0_transpose_item2<type == 7>(W, gain, K, N, WT, scr, it, (it + nw < hi) ? it + nw : -1, lane);
    } else if constexpr (type == 11) {
        const GAS f32x4* src = (const GAS f32x4*)(args->in[19] + (size_t)layer * 4194304); GAS u32x2g* dst = (GAS u32x2g*)((bf16*)(ws + cfg::WS_WQNT) + (size_t)layer * 4194304); const float* gq = args->in[10] + layer * 2048;
        const int n = 2048, lo = n * plo / 6, hi = n * phi / 6;
        for (int it = lo + widx; it < hi; it += nw) { f32x4 v[8]; const float g = gq[it];
#pragma unroll
            for (int q = 0; q < 8; ++q) v[q] = __builtin_nontemporal_load(src + (size_t)it * 512 + q * 64 + lane);
#pragma unroll
            for (int q = 0; q < 8; ++q) { u32x2g w; w.x = cvtpk(v[q].x * g, v[q].y * g); w.y = cvtpk(v[q].z * g, v[q].w * g); dst[(size_t)it * 512 + q * 64 + lane] = w; } }
    } else if constexpr (type == 9) {
        const GAS f32x4* src = (const GAS f32x4*)(args->in[8] + (size_t)layer * 8388608); GAS u32x2g* dst = (GAS u32x2g*)((bf16*)(ws + cfg::WS_CKV) + (size_t)layer * 8388608);
        const int n = 4096, lo = n * plo / 6, hi = n * phi / 6;
        for (int it = lo + widx; it < hi; it += nw) { f32x4 v[8];
#pragma unroll
            for (int q = 0; q < 8; ++q) v[q] = __builtin_nontemporal_load(src + (size_t)it * 512 + q * 64 + lane);
#pragma unroll
            for (int q = 0; q < 8; ++q) { u32x2g w; w.x = cvtpk(v[q].x, v[q].y); w.y = cvtpk(v[q].z, v[q].w); dst[(size_t)it * 512 + q * 64 + lane] = w; } }
    } else {
        const int n = 21312, lo = (int)((long)n * plo / 6), hi = (int)((long)n * phi / 6);
        for (int it = lo + widx; it < hi; it += nw) {
            int g, r = it; if (r < 960) g = 0; else if (r < 4992) { g = 1; r -= 960; } else { g = 2; r -= 4992; }
            const int W = (g == 0) ? 128 : (g == 1 ? 512 : 2048), per = (W - 8) / 2, jn = r / per, x = r - jn * per;
            const GAS f32x4* src = (const GAS f32x4*)((g == 0 ? args->in[3] : (g == 1 ? args->in[4] : args->in[5])) + ((size_t)jn * W + 8) * 1024 + (size_t)x * 2048);
            GAS f32x4* dst = (GAS f32x4*)(out + (g == 0 ? cfg::O_SW0 : (g == 1 ? cfg::O_SW1 : cfg::O_SW2)) + (size_t)jn * W * 1024 + (size_t)x * 2048);
            f32x4 v[8];
#pragma unroll
            for (int q = 0; q < 8; ++q) v[q] = __builtin_nontemporal_load(src + q * 64 + lane);
#pragma unroll
            for (int q = 0; q < 8; ++q) __builtin_nontemporal_store(v[q], dst + q * 64 + lane); }
    }
}
#define RJ(t, l, a, b) run_job<t>(l, a, b, widx, nw, args, ws, out, scr, lane)
__device__ __forceinline__ void run_slot(int slot, int widx, int nw, KArgs args, unsigned char* ws, float* out, LAS float* scr, int lane) {
    if (slot == 0) { RJ(0, 0, 0, 6); RJ(1, 0, 0, 6); RJ(4, 0, 0, 6); for (int l = 0; l < 4; ++l) RJ(5, l, 0, 6); RJ(11, 0, 0, 6); RJ(6, 0, 0, 6); RJ(7, 0, 0, 6); RJ(8, 0, 0, 6); }
    else if (slot == 1) { RJ(6, 1, 0, 6); RJ(11, 1, 0, 6); RJ(9, 0, 0, 6); RJ(2, 0, 0, 6); RJ(3, 0, 0, 6); RJ(4, 1, 0, 6); }
    else if (slot == 2) { RJ(6, 2, 0, 6); RJ(11, 2, 0, 6); RJ(7, 1, 0, 6); }
    else if (slot == 3) { RJ(6, 3, 0, 6); RJ(11, 3, 0, 6); RJ(7, 2, 0, 6); }
    else if (slot == 4) { RJ(8, 2, 0, 6); RJ(9, 2, 0, 6); RJ(2, 1, 0, 6); }
    else if (slot == 5) { RJ(7, 3, 0, 6); RJ(10, 0, 5, 6); }
    else if (slot == 6) { RJ(10, 0, 0, 3); }
    else if (slot == 7) { RJ(8, 1, 0, 6); RJ(9, 1, 0, 6); }
    else if (slot == 8) { RJ(0, 1, 0, 6); RJ(1, 1, 0, 6); RJ(4, 2, 0, 6); }
    else if (slot == 9) { RJ(3, 1, 0, 6); RJ(4, 3, 0, 6); RJ(9, 3, 0, 6); }
    else if (slot == 11) { RJ(10, 0, 3, 5); }
    else { RJ(8, 3, 0, 6); }
}
#undef RJ

template <int KS, int RT>
__device__ __forceinline__ void sg_trip(f32x4 (&acc)[RT], const bf16* bp, const bf16* ap, int K) {
    bf16x8 b[KS], a[KS][RT];
#pragma unroll
    for (int s = 0; s < KS; ++s) { b[s] = *(const GAS bf16x8*)(bp + 32 * s);
#pragma unroll
        for (int r = 0; r < RT; ++r) a[s][r] = *(const GAS bf16x8*)(ap + (size_t)r * 16 * K + 32 * s); }
#pragma unroll
    for (int s = 0; s < KS; ++s)
#pragma unroll
        for (int r = 0; r < RT; ++r) acc[r] = mfma16(b[s], a[s][r], acc[r]);
    __builtin_amdgcn_sched_group_barrier(0x020, (1 + RT) * KS, 0);
    __builtin_amdgcn_sched_group_barrier(0x008, RT * KS, 0);
}
template <class F>
__device__ __forceinline__ void sample_gemm(LAS unsigned char* lds, const bf16* A, const bf16* Bt, int N, int K, int wg, int nwg, const F& epi, int pmode = 0) {
    int tid_ = threadIdx.x; asm volatile("" : "+v"(tid_));
    const int tid = tid_, wid = __builtin_amdgcn_readfirstlane(tid >> 6), lane = tid & 63, fr = lane & 15, fq = lane >> 4;
    const int kw = K >> 3;
    LAS f32x4* red = (LAS f32x4*)lds;
    for (int task = wg; task < (N >> 3); task += nwg) { const int ct = task >> 1, half = task & 1;
        f32x4 acc[2];
#pragma unroll
        for (int r = 0; r < 2; ++r) acc[r] = (f32x4){0.f, 0.f, 0.f, 0.f};
        const bf16* bp = Bt + (size_t)(ct * 16 + fr) * K + wid * kw + 8 * fq;
        const bf16* ap = A + (size_t)(32 * half + fr) * K + wid * kw + 8 * fq;
        int k = 0;
        for (; k + 256 <= kw; k += 256) sg_trip<8, 2>(acc, bp + k, ap + k, K);
        for (; k + 64 <= kw; k += 64) sg_trip<2, 2>(acc, bp + k, ap + k, K);
#pragma unroll
        for (int r = 0; r < 2; ++r) red[(wid * 2 + r) * 64 + lane] = acc[r];
        __syncthreads();
        if (wid < 2) { f32x4 s = red[wid * 64 + lane];
#pragma unroll
            for (int w = 1; w < 8; ++w) s += red[(w * 2 + wid) * 64 + lane];
            epi(32 * half + 16 * wid + fr, ct * 16 + 4 * fq, s, lane); }
        __syncthreads();
    }
}
template <class F>
__device__ __forceinline__ void sample_gemm64(LAS unsigned char* lds, const bf16* A, const bf16* Bt, int N, int K, int wg, int nwg, const F& epi) {
    int tid_ = threadIdx.x; asm volatile("" : "+v"(tid_));
    const int tid = tid_, wid = __builtin_amdgcn_readfirstlane(tid >> 6), lane = tid & 63, fr = lane & 15, fq = lane >> 4;
    const int kw = K >> 3;
    LAS f32x4* red = (LAS f32x4*)lds;
    for (int ct = (wg >= 0) ? wg : (N >> 6); ct < (N >> 6); ct += nwg) {
        f32x4 acc[4][4];
#pragma unroll
        for (int c = 0; c < 4; ++c)
#pragma unroll
            for (int r = 0; r < 4; ++r) acc[c][r] = (f32x4){0.f, 0.f, 0.f, 0.f};
        const bf16* bp = Bt + (size_t)(ct * 64 + fr) * K + wid * kw + 8 * fq;
        const bf16* ap = A + (size_t)fr * K + wid * kw + 8 * fq;
        for (int k = 0; k < kw; k += 64) {
            bf16x8 b[2][4], a[2][4];
#pragma unroll
            for (int s = 0; s < 2; ++s)
#pragma unroll
                for (int c = 0; c < 4; ++c) { b[s][c] = *(const GAS bf16x8*)(bp + (size_t)c * 16 * K + k + 32 * s); a[s][c] = *(const GAS bf16x8*)(ap + (size_t)c * 16 * K + k + 32 * s); }
#pragma unroll
            for (int s = 0; s < 2; ++s)
#pragma unroll
                for (int c = 0; c < 4; ++c)
#pragma unroll
                    for (int r = 0; r < 4; ++r) acc[c][r] = mfma16(b[s][c], a[s][r], acc[c][r]);
            __builtin_amdgcn_sched_group_barrier(0x020, 16, 0);
            __builtin_amdgcn_sched_group_barrier(0x008, 32, 0);
        }
#pragma unroll
        for (int c = 0; c < 4; ++c)
#pragma unroll
            for (int r = 0; r < 4; ++r) red[(wid * 16 + c * 4 + r) * 64 + lane] = acc[c][r];
        __syncthreads();
#pragma unroll
        for (int q = 0; q < 2; ++q) { const int tile = wid * 2 + q, c = tile >> 2, r = tile & 3; f32x4 s = red[tile * 64 + lane];
#pragma unroll
            for (int w = 1; w < 8; ++w) s += red[(w * 16 + tile) * 64 + lane];
            epi(16 * r + fr, ct * 64 + c * 16 + 4 * fq, s, lane); }
        __syncthreads();
    }
}

__device__ __forceinline__ void sample_up_conv(LAS unsigned char* lds, const bf16* A, const bf16* Wt, int wg, int nwg, const LAS float* rs, const float* cw, const float* st, float* sfc, bf16* act) {
    int tid_ = threadIdx.x; asm volatile("" : "+v"(tid_));
    const int tid = tid_, wid = __builtin_amdgcn_readfirstlane(tid >> 6), lane = tid & 63, fr = lane & 15, fq = lane >> 4;
    const int kw = 256;
    LAS f32x4* red = (LAS f32x4*)lds;
    for (int ct = (wg >= 0) ? wg : 176; ct < 176; ct += nwg) {
        const int ch0 = 32 * ct, rowa = 256 * (ch0 >> 7) + (ch0 & 127);
        f32x4 acc[4][4];
#pragma unroll
        for (int c = 0; c < 4; ++c)
#pragma unroll
            for (int r = 0; r < 4; ++r) acc[c][r] = (f32x4){0.f, 0.f, 0.f, 0.f};
        const bf16* bp = Wt + (size_t)(rowa + fr) * 2048 + wid * kw + 8 * fq;
        const bf16* ap = A + (size_t)fr * 2048 + wid * kw + 8 * fq;
        for (int k = 0; k < kw; k += 64) {
            bf16x8 b[2][4], a[2][4];
#pragma unroll
            for (int s2 = 0; s2 < 2; ++s2)
#pragma unroll
                for (int c = 0; c < 4; ++c) { b[s2][c] = *(const GAS bf16x8*)(bp + (size_t)((c & 1) * 16 + (c >> 1) * 128) * 2048 + k + 32 * s2); a[s2][c] = *(const GAS bf16x8*)(ap + (size_t)c * 16 * 2048 + k + 32 * s2); }
#pragma unroll
            for (int s2 = 0; s2 < 2; ++s2)
#pragma unroll
                for (int c = 0; c < 4; ++c)
#pragma unroll
                    for (int r = 0; r < 4; ++r) acc[c][r] = mfma16(b[s2][c], a[s2][r], acc[c][r]);
            __builtin_amdgcn_sched_group_barrier(0x020, 16, 0);
            __builtin_amdgcn_sched_group_barrier(0x008, 32, 0);
        }
#pragma unroll
        for (int c = 0; c < 4; ++c)
#pragma unroll
            for (int r = 0; r < 4; ++r) red[(wid * 16 + c * 4 + r) * 64 + lane] = acc[c][r];
        __syncthreads();
        { const int r = wid & 3, cp = wid >> 2, ta = cp * 4 + r, tb = (2 + cp) * 4 + r;
          f32x4 va = red[ta * 64 + lane], vb = red[tb * 64 + lane];
#pragma unroll
          for (int w = 1; w < 8; ++w) { va += red[(w * 16 + ta) * 64 + lane]; vb += red[(w * 16 + tb) * 64 + lane]; }
          const int row = 16 * r + fr, n = row >> 3, t = row & 7, ch = ch0 + 16 * cp + 4 * fq;
          const float rsv = rs[row]; va = va * rsv; vb = vb * rsv;
          if (t >= 6) { float* d = sfc + ((size_t)n * 2 + (t - 6)) * cfg::UP + ch; *(GAS f32x4*)d = va; *(GAS f32x4*)(d + cfg::DFF) = vb; }
          const float* sp = st + ((size_t)n * 2) * cfg::UP + ch;
          const f32x4 sa0 = *(const GAS f32x4*)sp, sa1 = *(const GAS f32x4*)(sp + cfg::UP), sb0 = *(const GAS f32x4*)(sp + cfg::DFF), sb1 = *(const GAS f32x4*)(sp + cfg::UP + cfg::DFF);
          const f32x4 wa0 = *(const GAS f32x4*)(cw + ch), wa1 = *(const GAS f32x4*)(cw + cfg::UP + ch), wa2 = *(const GAS f32x4*)(cw + 2 * cfg::UP + ch);
          const f32x4 wb0 = *(const GAS f32x4*)(cw + cfg::DFF + ch), wb1 = *(const GAS f32x4*)(cw + cfg::UP + cfg::DFF + ch), wb2 = *(const GAS f32x4*)(cw + 2 * cfg::UP + cfg::DFF + ch);
          f32x4 a1, a2, b1, b2;
#pragma unroll
          for (int i = 0; i < 4; ++i) { a1[i] = __shfl_up(va[i], 1, 16); a2[i] = __shfl_up(va[i], 2, 16); b1[i] = __shfl_up(vb[i], 1, 16); b2[i] = __shfl_up(vb[i], 2, 16); }
          if (t == 0) { a1 = sa1; a2 = sa0; b1 = sb1; b2 = sb0; } else if (t == 1) { a2 = sa1; b2 = sb1; }
          const f32x4 ca = wa0 * a2 + wa1 * a1 + wa2 * va, cb = wb0 * b2 + wb1 * b1 + wb2 * vb;
          f32x4 o; o[0] = ca[0] / (1.0f + __expf(-ca[0])) * cb[0]; o[1] = ca[1] / (1.0f + __expf(-ca[1])) * cb[1]; o[2] = ca[2] / (1.0f + __expf(-ca[2])) * cb[2]; o[3] = ca[3] / (1.0f + __expf(-ca[3])) * cb[3];
          u32x2g w2; w2.x = cvtpk(o[0], o[1]); w2.y = cvtpk(o[2], o[3]); *(GAS u32x2g*)(act + (size_t)row * cfg::DFF + ch) = w2; }
        __syncthreads();
    }
}
__device__ __forceinline__ void sample_rstd_table(LAS float* tab, const float* ssqs) {
    int tid_ = threadIdx.x; asm volatile("" : "+v"(tid_));
    const int tid = tid_, row = tid >> 3, part = tid & 7;
    const GAS f32x4* p = (const GAS f32x4*)(ssqs + (size_t)row * 128 + part * 16);
    float s = 0.f;
#pragma unroll
    for (int q = 0; q < 4; ++q) { const f32x4 a = p[q]; s += (a.x + a.y) + (a.z + a.w); }
    s += __shfl_xor(s, 1); s += __shfl_xor(s, 2); s += __shfl_xor(s, 4);
    if (part == 0) tab[row] = 1.0f / sqrtf(s * (1.0f / 2048.0f) + cfg::EPS);
    __syncthreads();
}
constexpr int DA_KSTR = 272, DA_VSTR = 288, DA_VOFF = 256 * DA_KSTR;
static_assert(DA_VOFF + 256 * DA_VSTR <= SCR_BYTES, "dilated attention LDS");
struct DaUnit { int d, r, b, cq; size_t rowbase; int g, h; };
__device__ __forceinline__ DaUnit da_decode(int u) {
    DaUnit x; const int n = u / 192, g = (u / 64) % 3, h = (u >> 4) & 3, xx = u & 15;
    const int lg = (g == 0) ? 0 : (g == 1 ? 2 : 4); x.d = 1 << lg; x.r = xx & (x.d - 1); x.b = xx >> lg; x.cq = g * 1536 + h * 128; x.rowbase = (size_t)n * 2048; x.g = g; x.h = h; return x;
}
__device__ __forceinline__ void da_load(const bf16* QKV, const DaUnit& x, int tid, u32x4g (&kr)[8], u32x4g (&vr)[8]) {
#pragma unroll
    for (int x8 = 0; x8 < 8; ++x8) { const int c = tid + 512 * x8, row = c >> 4, ch = c & 15, kk = 128 * (x.b - 1) + row;
        kr[x8] = (u32x4g){0u, 0u, 0u, 0u}; vr[x8] = (u32x4g){0u, 0u, 0u, 0u};
        if (kk >= 0) { const bf16* src = QKV + (x.rowbase + (size_t)kk * x.d + x.r) * cfg::NQKV + x.cq + ch * 8; kr[x8] = *(const GAS u32x4g*)(src + 512); vr[x8] = *(const GAS u32x4g*)(src + 1024); } }
}
__device__ __forceinline__ void dattn_phase(LAS unsigned char* lds, const bf16* QKV, bf16* OG, float* LSE, int wg, int nwg) {
    int tid_ = threadIdx.x; asm volatile("" : "+v"(tid_));
    const int tid = tid_, wid = __builtin_amdgcn_readfirstlane(tid >> 6), lane = tid & 63, fr = lane & 15, fq = lane >> 4;
    LAS unsigned char* Ks = lds; LAS unsigned char* Vs = lds + DA_VOFF;
    if (wg >= 768) return;
    u32x4g kr[8], vr[8];
    DaUnit x = da_decode(wg);
    da_load(QKV, x, tid, kr, vr);
    for (int u = wg; u < 768; u += nwg) {
#pragma unroll
        for (int x8 = 0; x8 < 8; ++x8) { const int c = tid + 512 * x8, row = c >> 4, ch = c & 15;
            *(LAS u32x4g*)(Ks + row * DA_KSTR + ch * 16) = kr[x8]; *(LAS u32x4g*)(Vs + row * DA_VSTR + ch * 16) = vr[x8]; }
        const int b = x.b, d = x.d, r = x.r, cq = x.cq, g = x.g, h = x.h; const size_t rowbase = x.rowbase;
        const int iq = 128 * b + 16 * wid + fr;
        const size_t qrow = rowbase + (size_t)iq * d + r;
        bf16x8 qa[4];
#pragma unroll
        for (int ks = 0; ks < 4; ++ks) qa[ks] = *(const GAS bf16x8*)(QKV + qrow * cfg::NQKV + cq + 32 * ks + 8 * fq);
        __syncthreads();
        if (u + nwg < 768) { x = da_decode(u + nwg); da_load(QKV, x, tid, kr, vr); }
        f32x4 st[16];
#pragma unroll
        for (int kt = 0; kt < 16; ++kt) { st[kt] = (f32x4){0.f, 0.f, 0.f, 0.f};
#pragma unroll
            for (int ks = 0; ks < 4; ++ks) { const bf16x8 kf = *(const LAS bf16x8*)(Ks + (16 * kt + fr) * DA_KSTR + (32 * ks + 8 * fq) * 2); st[kt] = mfma16(kf, qa[ks], st[kt]); } }
        float mx = -1e30f;
#pragma unroll
        for (int kt = 0; kt < 16; ++kt)
#pragma unroll
            for (int i = 0; i < 4; ++i) { const int ik = 128 * (b - 1) + 16 * kt + 4 * fq + i, dist = iq - ik; const bool valid = (dist >= 0) && (dist <= 128) && (ik >= 0);
                const float s = valid ? st[kt][i] : -1e30f; st[kt][i] = s; mx = fmaxf(mx, s); }
        mx = fmaxf(mx, __shfl_xor(mx, 16)); mx = fmaxf(mx, __shfl_xor(mx, 32));
        float sum = 0.f;
#pragma unroll
        for (int kt = 0; kt < 16; ++kt)
#pragma unroll
            for (int i = 0; i < 4; ++i) { const float p = exp2f(st[kt][i] - mx); st[kt][i] = p; sum += p; }
        sum += __shfl_xor(sum, 16); sum += __shfl_xor(sum, 32);
        bf16x8 pb[8];
#pragma unroll
        for (int s2 = 0; s2 < 8; ++s2) { u32x4g w; w.x = cvtpk(st[2 * s2][0], st[2 * s2][1]); w.y = cvtpk(st[2 * s2][2], st[2 * s2][3]); w.z = cvtpk(st[2 * s2 + 1][0], st[2 * s2 + 1][1]); w.w = cvtpk(st[2 * s2 + 1][2], st[2 * s2 + 1][3]);
            pb[s2] = __builtin_bit_cast(bf16x8, w); }
        f32x4 ot[8];
#pragma unroll
        for (int c = 0; c < 8; ++c) ot[c] = (f32x4){0.f, 0.f, 0.f, 0.f};
        const int q4 = fr >> 2, p4 = fr & 3;
        const LAS unsigned char* vb = Vs + (4 * fq + q4) * DA_VSTR + p4 * 8;
#pragma unroll
        for (int s2 = 0; s2 < 8; ++s2)
#pragma unroll
            for (int c = 0; c < 8; ++c) { const s16x4g v0 = ldtr(vb + (32 * s2) * DA_VSTR + c * 32), v1 = ldtr(vb + (32 * s2 + 16) * DA_VSTR + c * 32);
                const bf16x8 vf = (bf16x8){v0[0], v0[1], v0[2], v0[3], v1[0], v1[1], v1[2], v1[3]}; ot[c] = mfma16(vf, pb[s2], ot[c]); }
        const float inv = 1.0f / sum;
        bf16* orow = OG + ((size_t)g * cfg::MT + qrow) * 512 + h * 128 + 4 * fq;
#pragma unroll
        for (int c = 0; c < 8; ++c) { u32x2g w; w.x = cvtpk(ot[c][0] * inv, ot[c][1] * inv); w.y = cvtpk(ot[c][2] * inv, ot[c][3] * inv); *(GAS u32x2g*)(orow + 16 * c) = w; }
        if (fq == 0) LSE[((size_t)g * cfg::MT + qrow) * 4 + h] = (mx + log2f(sum)) * cfg::LN2;
        __syncthreads();
    }
}

__device__ __forceinline__ void dattn_sample(LAS float* qs  , const float* QKVS, const float* cache0, const float* cache1, const float* cache2, int j, bf16* OG, float* LSE, int task, int lane) {
    const int n = task / 96, t = (task / 12) & 7, g = (task % 12) >> 2, h = task & 3;
    const int d = (g == 0) ? 1 : (g == 1 ? 4 : 16), W = (g == 0) ? 128 : (g == 1 ? 512 : 2048);
    const float* cache = ((g == 0) ? cache0 : (g == 1 ? cache1 : cache2)) + (size_t)(j * 8 + n) * W * 1024 + h * 128;
    const float* newb = QKVS + (size_t)(n * 8) * cfg::NQKV + g * 1536 + h * 128;
    const float* qp = newb + (size_t)t * cfg::NQKV;
    { const f32x2g qv = *(const GAS f32x2g*)(qp + 2 * lane); qs[2 * lane] = qv.x; qs[2 * lane + 1] = qv.y; }
    LDS_WAIT(); asm volatile("" ::: "memory");
    float sc[3];
#pragma unroll
    for (int rnd = 0; rnd < 3; ++rnd) { const int m = lane + 64 * rnd; float acc = -1e30f;
        if (m <= 128) { const int idx = W + t - d * m; const float* kp = (idx < W) ? (cache + (size_t)idx * 1024) : (newb + (size_t)(idx - W) * cfg::NQKV + 512);
            float a = 0.f;
#pragma unroll 8
            for (int e4 = 0; e4 < 32; ++e4) { const f32x4 kv = *(const GAS f32x4*)(kp + 4 * e4); const f32x4 qv = *(const LAS f32x4*)(qs + 4 * e4); a += (kv.x * qv.x + kv.y * qv.y) + (kv.z * qv.z + kv.w * qv.w); }
            acc = a * 0.08838834764831845f; }
        sc[rnd] = acc; }
    const float mx = wave_max(fmaxf(fmaxf(sc[0], sc[1]), sc[2]));
    float p0 = __expf(sc[0] - mx), p1 = __expf(sc[1] - mx), p2 = (lane == 0) ? __expf(sc[2] - mx) : 0.f;
    const float sum = wave_sum(p0 + p1 + p2);
    float o0 = 0.f, o1 = 0.f;
    for (int m0 = 0; m0 < 128; m0 += 8) {
        f32x2g vv[8]; float pv[8];
#pragma unroll
        for (int q = 0; q < 8; ++q) { const int m = m0 + q, idx = W + t - d * m; const float* vp = (idx < W) ? (cache + (size_t)idx * 1024 + 512) : (newb + (size_t)(idx - W) * cfg::NQKV + 1024);
            vv[q] = *(const GAS f32x2g*)(vp + 2 * lane); pv[q] = (m0 < 64) ? __shfl(p0, m) : __shfl(p1, m - 64); }
#pragma unroll
        for (int q = 0; q < 8; ++q) { o0 += pv[q] * vv[q].x; o1 += pv[q] * vv[q].y; } }
    { const int idx = W + t - d * 128; const float* vp = cache + (size_t)idx * 1024 + 512;
      const float pv = __shfl(p2, 0); const f32x2g vv = *(const GAS f32x2g*)(vp + 2 * lane); o0 += pv * vv.x; o1 += pv * vv.y; }
    const float inv = 1.0f / sum; const size_t row = (size_t)cfg::MP + n * 8 + t;
    *(GAS unsigned*)(OG + ((size_t)g * cfg::MT + row) * 512 + h * 128 + 2 * lane) = cvtpk(o0 * inv, o1 * inv);
    if (lane == 0) LSE[((size_t)g * cfg::MT + row) * 4 + h] = mx + __logf(sum);
    LDS_WAIT(); asm volatile("" ::: "memory");
}


__device__ __forceinline__ void dattn_sample_half(LAS float* qs, LAS float* xch, const float* QKVS, const float* cache0, const float* cache1, const float* cache2, int j, int task, int half, int lane) {
    const int n = task / 96, t = (task / 12) & 7, g = (task % 12) >> 2, h = task & 3;
    const int d = (g == 0) ? 1 : (g == 1 ? 4 : 16), W = (g == 0) ? 128 : (g == 1 ? 512 : 2048);
    const float* cache = ((g == 0) ? cache0 : (g == 1 ? cache1 : cache2)) + (size_t)(j * 8 + n) * W * 1024 + h * 128;
    const float* newb = QKVS + (size_t)(n * 8) * cfg::NQKV + g * 1536 + h * 128;
    const float* qp = newb + (size_t)t * cfg::NQKV;
    const f32x2g qv2 = *(const GAS f32x2g*)(qp + 2 * lane);
    { qs[2 * lane] = qv2.x; qs[2 * lane + 1] = qv2.y; }
    f32x2g k128 = (f32x2g){0.f, 0.f};
    if (half == 0) k128 = *(const GAS f32x2g*)(cache + (size_t)t * 1024 + 2 * lane);
    LDS_WAIT(); asm volatile("" ::: "memory");
    float s0;
    { const int m = lane + 64 * half, idx = W + t - d * m; const float* kp = (idx < W) ? (cache + (size_t)idx * 1024) : (newb + (size_t)(idx - W) * cfg::NQKV + 512);
      float a = 0.f;
#pragma unroll 16
      for (int e4 = 0; e4 < 32; ++e4) { const f32x4 kv = *(const GAS f32x4*)(kp + 4 * e4); const f32x4 qv = *(const LAS f32x4*)(qs + 4 * e4); a += (kv.x * qv.x + kv.y * qv.y) + (kv.z * qv.z + kv.w * qv.w); }
      s0 = a * 0.08838834764831845f; }
    const float s128 = (half == 0) ? wave_sum(k128.x * qv2.x + k128.y * qv2.y) * 0.08838834764831845f : -1e30f;
    const float mx = fmaxf(wave_max(s0), s128);
    const float p0 = __expf(s0 - mx), p128 = (half == 0) ? __expf(s128 - mx) : 0.f;
    const float sum = wave_sum(p0) + p128;
    float o0 = 0.f, o1 = 0.f;
#pragma unroll 1
    for (int m0 = 0; m0 < 64; m0 += 16) {
        f32x2g vv[16]; float pv[16];
#pragma unroll
        for (int q = 0; q < 16; ++q) { const int m = 64 * half + m0 + q, idx = W + t - d * m; const float* vp = (idx < W) ? (cache + (size_t)idx * 1024 + 512) : (newb + (size_t)(idx - W) * cfg::NQKV + 1024);
            vv[q] = *(const GAS f32x2g*)(vp + 2 * lane); pv[q] = __shfl(p0, m0 + q); }
#pragma unroll
        for (int q = 0; q < 16; ++q) { o0 += pv[q] * vv[q].x; o1 += pv[q] * vv[q].y; } }
    if (half == 0) { const f32x2g vv = *(const GAS f32x2g*)(cache + (size_t)t * 1024 + 512 + 2 * lane); o0 += p128 * vv.x; o1 += p128 * vv.y; }
    LAS float* x = xch + half * 130;
    x[2 * lane] = o0; x[2 * lane + 1] = o1; if (lane == 0) { x[128] = mx; x[129] = sum; }
}
__device__ __forceinline__ void dattn_sample_merge(const LAS float* xch, bf16* OG, float* LSE, int task, int lane) {
    const int n = task / 96, t = (task / 12) & 7, g = (task % 12) >> 2, h = task & 3;
    const float m0 = xch[128], s0 = xch[129], m1 = xch[130 + 128], s1 = xch[130 + 129];
    const float M = fmaxf(m0, m1), e0 = __expf(m0 - M), e1 = __expf(m1 - M), sum = s0 * e0 + s1 * e1, inv = 1.0f / sum;
    const float o0 = (xch[2 * lane] * e0 + xch[130 + 2 * lane] * e1) * inv, o1 = (xch[2 * lane + 1] * e0 + xch[130 + 2 * lane + 1] * e1) * inv;
    const size_t row = (size_t)cfg::MP + n * 8 + t;
    *(GAS unsigned*)(OG + ((size_t)g * cfg::MT + row) * 512 + h * 128 + 2 * lane) = cvtpk(o0, o1);
    if (lane == 0) LSE[((size_t)g * cfg::MT + row) * 4 + h] = M + __logf(sum);
}
constexpr int MA_KSTR = 1040, MA_VSTR = 544, MA_BUF = 64 * MA_KSTR;
static_assert(2 * MA_BUF <= SCR_BYTES && 64 * MA_VSTR <= MA_BUF, "memory attention LDS");
template <bool FROMP  >
__device__ __forceinline__ void memattn_unit(LAS unsigned char* lds, const bf16* Qb  , int row0  , bool sample  , const bf16* kbase  , const bf16* vbase, bf16* Ob  ) {
    int tid_ = threadIdx.x; asm volatile("" : "+v"(tid_));
    const int tid = tid_, lane = tid & 63, fr = lane & 15, fq = lane >> 4, wid = __builtin_amdgcn_readfirstlane(tid >> 6);
    const int qrow_i = sample ? row0 + (fr & 7) : row0 + wid * 16 + fr; const bool wr_ok = sample ? (wid == 0 && fr < 8) : true;
    bf16x8 qa[16];
    f32x4 st[16]; bf16x8 pb[8]; f32x4 ot[16]; float inv = 1.f;
    if constexpr (FROMP) {
#pragma unroll
        for (int s2 = 0; s2 < 8; ++s2) { const GAS char* pp = (const GAS char*)Qb + (unsigned)(qrow_i * 2048 + (32 * s2 + 4 * fq) * 2); const u32x2g lo = *(const GAS u32x2g*)pp, hi = *(const GAS u32x2g*)(pp + 32);
            pb[s2] = __builtin_bit_cast(bf16x8, (u32x4g){lo.x, lo.y, hi.x, hi.y}); }
    } else {
#pragma unroll
        for (int ks = 0; ks < 16; ++ks) qa[ks] = *(const GAS bf16x8*)((const GAS char*)Qb + (unsigned)(qrow_i * 4096 + ks * 64 + fq * 16));
#pragma unroll
        for (int kt = 0; kt < 16; ++kt) st[kt] = (f32x4){0.f, 0.f, 0.f, 0.f};
    }
    u32x4g pr[8];
    const unsigned vk = (unsigned)((tid >> 6) * 8192 + (tid & 63) * 16), vv = (unsigned)((tid >> 5) * 8192 + (tid & 31) * 16);
    const unsigned lk = (unsigned)((tid >> 6) * MA_KSTR + (tid & 63) * 16), lv = (unsigned)((tid >> 5) * MA_VSTR + (tid & 31) * 16);
#define MA_LOAD(c) do { if ((c) < 4) { const GAS char* src_ = (const GAS char*)(kbase + (size_t)((c) * 64) * 4096); _Pragma("unroll") for (int x8 = 0; x8 < 8; ++x8) pr[x8] = *(const GAS u32x4g*)(src_ + x8 * 65536 + vk); } \
        else { const GAS char* src_ = (const GAS char*)(vbase + (size_t)((((c) - 4) & 3) * 64) * 4096 + (((c) - 4) >> 2) * 256); _Pragma("unroll") for (int x8 = 0; x8 < 4; ++x8) pr[x8] = *(const GAS u32x4g*)(src_ + x8 * 131072 + vv); } } while (0)
#define MA_STORE(c) do { LAS unsigned char* dst_ = lds + ((c) & 1) * MA_BUF; if ((c) < 4) { _Pragma("unroll") for (int x8 = 0; x8 < 8; ++x8) *(LAS u32x4g*)(dst_ + x8 * 8 * MA_KSTR + lk) = pr[x8]; } \
        else { _Pragma("unroll") for (int x8 = 0; x8 < 4; ++x8) *(LAS u32x4g*)(dst_ + x8 * 16 * MA_VSTR + lv) = pr[x8]; } } while (0)
    constexpr int C0 = FROMP ? 4 : 0;
    MA_LOAD(C0);
    const int q4 = fr >> 2, p4 = fr & 3;
#pragma unroll
    for (int c = C0; c < 12; ++c) {
        MA_STORE(c);
        __syncthreads();
        if (c < 11) MA_LOAD(c + 1);
        const LAS unsigned char* buf = lds + (c & 1) * MA_BUF;
        if (c < 4) {
#pragma unroll
            for (int k4 = 0; k4 < 4; ++k4)
#pragma unroll
                for (int ks = 0; ks < 16; ++ks) { const bf16x8 kf = *(const LAS bf16x8*)(buf + (16 * k4 + fr) * MA_KSTR + (32 * ks + 8 * fq) * 2); st[4 * c + k4] = mfma16(kf, qa[ks], st[4 * c + k4]); }
            if (c == 3) {
                float mx = -1e30f;
#pragma unroll
                for (int kt = 0; kt < 16; ++kt) mx = fmaxf(mx, fmaxf(fmaxf(st[kt][0], st[kt][1]), fmaxf(st[kt][2], st[kt][3])));
                mx = fmaxf(mx, __shfl_xor(mx, 16)); mx = fmaxf(mx, __shfl_xor(mx, 32));
                float s = 0.f;
#pragma unroll
                for (int kt = 0; kt < 16; ++kt)
#pragma unroll
                    for (int i = 0; i < 4; ++i) { const float p = exp2f(st[kt][i] - mx); st[kt][i] = p; s += p; }
                s += __shfl_xor(s, 16); s += __shfl_xor(s, 32); inv = 1.0f / s;
#pragma unroll
                for (int s2 = 0; s2 < 8; ++s2) { u32x4g w; w.x = cvtpk(st[2 * s2][0], st[2 * s2][1]); w.y = cvtpk(st[2 * s2][2], st[2 * s2][3]); w.z = cvtpk(st[2 * s2 + 1][0], st[2 * s2 + 1][1]); w.w = cvtpk(st[2 * s2 + 1][2], st[2 * s2 + 1][3]);
                    pb[s2] = __builtin_bit_cast(bf16x8, w); }
            }
        } else {
            const int kc = (c - 4) & 3, eh = (c - 4) >> 2;
            const LAS unsigned char* vb = buf + (4 * fq + q4) * MA_VSTR + p4 * 8;
#pragma unroll
            for (int s2 = 0; s2 < 2; ++s2)
#pragma unroll
                for (int ec = 0; ec < 16; ++ec) { const s16x4g v0 = ldtr(vb + (32 * s2) * MA_VSTR + ec * 32), v1 = ldtr(vb + (32 * s2 + 16) * MA_VSTR + ec * 32);
                    const bf16x8 vf = (bf16x8){v0[0], v0[1], v0[2], v0[3], v1[0], v1[1], v1[2], v1[3]};
                    ot[ec] = mfma16(vf, pb[2 * kc + s2], (kc == 0 && s2 == 0) ? (f32x4){0.f, 0.f, 0.f, 0.f} : ot[ec]); }
            if (kc == 3) {
                if (wr_ok) { GAS char* orow = (GAS char*)Ob + (unsigned)(qrow_i * 4096 + eh * 512 + fq * 8);
#pragma unroll
                    for (int ec = 0; ec < 16; ++ec) { u32x2g w; w.x = cvtpk(ot[ec][0] * inv, ot[ec][1] * inv); w.y = cvtpk(ot[ec][2] * inv, ot[ec][3] * inv); *(GAS u32x2g*)(orow + 32 * ec) = w; } }
            }
        }
    }
#undef MA_LOAD
#undef MA_STORE
    __syncthreads();
}
struct SEpiF32 {
    float* dst; int ld; const LAS float* rs; float* out; int mode; int idx;
    __device__ __forceinline__ void operator()(int row, int col, f32x4 v, int lane) const {
        v = v * rs[row];
        const int n = row >> 3, t = row & 7;
        if (mode == 2) { const int qq = col >> 8, w8 = col & 255; col = (w8 < 128) ? 128 * qq + w8 : cfg::DFF + 128 * qq + (w8 - 128); }
        *(GAS f32x4*)(dst + (size_t)row * ld + col) = v;
        if (mode == 1) { const int g = col / 1536, rem = col - g * 1536, w = rem >> 9, c512 = rem & 511;
            if (w >= 1) { const int W = (g == 0) ? 128 : (g == 1 ? 512 : 2048); float* sw = out + (g == 0 ? cfg::O_SW0 : (g == 1 ? cfg::O_SW1 : cfg::O_SW2));
                *(GAS f32x4*)(sw + ((((size_t)(idx * 8 + n) * W + (W - 8 + t)) * 2 + (w - 1)) * 512) + c512) = v; } }
        else if (mode == 2) { if (t >= 6) *(GAS f32x4*)(out + cfg::O_SFC + ((size_t)(idx * 8 + n) * 2 + (t - 6)) * cfg::UP + col) = v; }
    }
};
struct SEpiBf16 {
    bf16* dst; int ld; const LAS float* rs; float scale;
    __device__ __forceinline__ void operator()(int row, int col, f32x4 v, int lane) const {
        v = v * (rs[row] * scale); u32x2g w; w.x = cvtpk(v[0], v[1]); w.y = cvtpk(v[2], v[3]); *(GAS u32x2g*)(dst + (size_t)row * ld + col) = w;
    }
};
struct SEpiResid {
    float* Y; bf16* YB; float* ssqs;
    __device__ __forceinline__ void operator()(int row, int col, f32x4 v, int lane) const {
        f32x4 y = *(const GAS f32x4*)(Y + (size_t)row * 2048 + col); y += v;
        *(GAS f32x4*)(Y + (size_t)row * 2048 + col) = y; u32x2g w; w.x = cvtpk(y[0], y[1]); w.y = cvtpk(y[2], y[3]); *(GAS u32x2g*)(YB + (size_t)row * 2048 + col) = w;
        float p = (y[0] * y[0] + y[1] * y[1]) + (y[2] * y[2] + y[3] * y[3]); p += __shfl_xor(p, 16); p += __shfl_xor(p, 32);
        if ((lane >> 4) == 0) ssqs[(size_t)row * 128 + (col >> 4)] = p;
    }
};

#ifndef MK_CUTS_ON
#define MK_CUTS_ON 0
#endif
__global__ void __launch_bounds__(NTHREADS, 2) mk_fwd(Args args) {
    extern __shared__ __attribute__((aligned(16))) unsigned char lds_raw[];
    LAS unsigned char* lds = (LAS unsigned char*)lds_raw;
    volatile LAS unsigned* MISC = (volatile LAS unsigned*)(lds + MISC_OFF);
    const int G = gridDim.x, bx = blockIdx.x;
#define NGW (G * NWAVES)
#define NGT (G * NTHREADS)
    gu32* ctl = (gu32*)(args.ws + cfg::WS_CTL);
    for (int u = threadIdx.x; u < (LDS_BYTES - MISC_OFF) / 4; u += NTHREADS) ((LAS unsigned*)(lds + MISC_OFF))[u] = 0u;
    __syncthreads();
    (void)xcd_barrier_post((unsigned*)ctl + 4096, MISC + 8);
#define PH_ON true
#define PH_END do { XcdBarrier b_; b_.bar = (unsigned*)(((KArgs)__builtin_amdgcn_kernarg_segment_ptr())->ws + cfg::WS_CTL) + 4096; b_.x = xb_xcc_id(); b_.st = (volatile LAS unsigned*)(lds + MISC_OFF) + 8; \
        xcd_barrier(b_); if ((PROBE_MASK >> 4) & 1) xcd_barrier(b_); } while (0)
#define PH_BEGIN(grp) if (PH_ON) for (int rep_ = 0; rep_ < ((((PROBE_MASK) >> (grp)) & 1) ? 2 : 1); ++rep_) { PH_VARS
#define PH_VARS int tid_ = threadIdx.x; asm volatile("" : "+v"(tid_)); const int tid = tid_, lane = tid & 63, wave = __builtin_amdgcn_readfirstlane(tid >> 6); \
    const int gw = bx * NWAVES + wave, gt = bx * NTHREADS + tid; (void)gw; (void)gt; (void)lane; \
    KArgs ka = (KArgs)__builtin_amdgcn_kernarg_segment_ptr(); asm volatile("" : "+s"(ka)); unsigned char* ws = ka->ws; float* out = ka->out; (void)out;
#define Wqkv ((bf16*)(ws + cfg::WS_WQKV))
#define Woa ((bf16*)(ws + cfg::WS_WOA))
#define Winb ((bf16*)(ws + cfg::WS_WINB))
#define Wob ((bf16*)(ws + cfg::WS_WOB))
#define Wq ((bf16*)(ws + cfg::WS_WQ))
#define Wkv ((bf16*)(ws + cfg::WS_WKV))
#define Wo ((bf16*)(ws + cfg::WS_WO))
#define Wup ((bf16*)(ws + cfg::WS_WUP))
#define Wdn ((bf16*)(ws + cfg::WS_WDN))
#define Y ((float*)(ws + cfg::WS_Y))
#define YB ((bf16*)(ws + cfg::WS_YB))
#define SSQ ((float*)(ws + cfg::WS_SSQ))
#define SSQS ((float*)(ws + cfg::WS_SSQS))
#define MEMB ((bf16*)(ws + cfg::WS_MEMB))
#define SSQM ((float*)(ws + cfg::WS_SSQM))
#define KVB ((bf16*)(ws + cfg::WS_KVB))
#define CKV ((bf16*)(ws + cfg::WS_CKV))
#define BIG ((bf16*)(ws + cfg::WS_BIG))
#define ACT ((bf16*)(ws + cfg::WS_ACT))
#define QM ((bf16*)(ws + cfg::WS_QM))
#define OM ((bf16*)(ws + cfg::WS_OM))
#define OG ((bf16*)(ws + cfg::WS_OG))
#define LSE ((float*)(ws + cfg::WS_LSE))
#define MRG ((bf16*)(ws + cfg::WS_MRG))
#define QKVS ((float*)(ws + cfg::WS_QKVS))
#define U3S ((float*)(ws + cfg::WS_U3S))
#define US ((float*)(ws + cfg::WS_US))
#define WQNT ((bf16*)(ws + cfg::WS_WQNT))
#define MKT ((bf16*)(ws + cfg::WS_MKT))
#define VWT ((bf16*)(ws + cfg::WS_VWT))
#define Ys (Y + (size_t)cfg::MP * 2048)
#define YBs (YB + (size_t)cfg::MP * 2048)
    LAS float* const rstab = (LAS float*)(lds + 131072);

    PH_BEGIN(0)
        LAS float* scr = (LAS float*)(lds + wave * 17408);
        run_slot(0, gw, NGW, ka, ws, out, scr, lane);
        for (int m = gw; m < cfg::MT + cfg::MM; m += NGW) {
            if (m < cfg::MP) p0_row(ka->in[0] + (size_t)m * 2048, nullptr, YB + (size_t)m * 2048, SSQ + (size_t)m * 32, 32, lane);
            else if (m < cfg::MT) { const int s = m - cfg::MP; p0_row(ka->in[1] + (size_t)s * 2048, Ys + (size_t)s * 2048, YBs + (size_t)s * 2048, SSQS + (size_t)s * 128, 128, lane); }
            else { const int s = m - cfg::MT; p0_row(ka->in[2] + (size_t)s * 2048, nullptr, MEMB + (size_t)s * 2048, SSQM + (size_t)s * 32, 32, lane); }
        }
    }
    PH_END;

    PH_BEGIN(1)
        pg8::Gemm g{MEMB, Wkv, cfg::MM, 16384, 2048}; pg8::StaticOrder S; S.init(cfg::MM, 16384, G, bx);
        ep::EpiKV E{KVB, SSQM, out, (LAS float*)(lds + 131072 + 1024)};
        pg8::gemm_phase<ep::EpiKV, pg8::StaticOrder, true, true>(lds, g, S, E);
    }
    if (MK_CUTS_ON) { PH_END; }

    for (int layer = 0; layer < 4; ++layer) {
        const int j = layer >> 1;
        if ((layer & 1) == 0) {
            PH_BEGIN(1)
                { pg8::Gemm g{YB, Wqkv + (size_t)j * 4608 * 2048, cfg::MP, cfg::NQKV, 2048}; pg8::StaticOrder S; S.init(cfg::MP, cfg::NQKV, G, bx);
                  ep::EpiQKV E{BIG, SSQ, out, j, 0.08838834764831845f * cfg::LOG2E, (LAS float*)(lds + 131072 + 1024)};
                  pg8::gemm_phase<ep::EpiQKV, pg8::StaticOrder, true, true>(lds, g, S, E); }
                sample_rstd_table(rstab, SSQS);
                SEpiF32 se{QKVS, cfg::NQKV, rstab, out, 1, j};
                sample_gemm64(lds, YBs, Wqkv + (size_t)j * 4608 * 2048, cfg::NQKV, 2048, G == 256 ? bx - 64 : bx, G == 256 ? 192 : G, se);
                if (G == 256 && bx >= 64) run_slot(layer == 0 ? 1 : 4, (bx - 64) * NWAVES + wave, 192 * NWAVES, ka, ws, out, (LAS float*)(lds + wave * 17408), lane);
                else if (G != 256) run_slot(layer == 0 ? 1 : 4, gw, NGW, ka, ws, out, (LAS float*)(lds + wave * 17408), lane);
                if (PROBE_MASK) __syncthreads();
            }
            PH_END;
            PH_BEGIN(2)
                dattn_phase(lds, BIG, OG, LSE, (G % 8 == 0) ? (bx % 8) * (G / 8) + bx / 8 : bx, G);
                { const int tw = wave % 3, half = wave / 3;
                  for (int rnd = 0; rnd * 3 * G < 768; ++rnd) { const int task = bx + G * tw + rnd * 3 * G; const bool on = (wave < 6) && (task < 768);
                      LAS float* xch = (LAS float*)(lds + 8192) + tw * 260;
                      if (on) dattn_sample_half((LAS float*)(lds + wave * 1024), xch, QKVS, ka->in[3], ka->in[4], ka->in[5], j, task, half, lane);
                      __syncthreads();
                      if (on && half == 0) dattn_sample_merge(xch, OG, LSE, task, lane);
                      __syncthreads(); } }
            }
            PH_END;
            PH_BEGIN(2)
                for (int i0 = gt; i0 < cfg::MT * 64; i0 += 2 * NGT) {
                    float l0[2], l1[2], l2[2]; u32x4g a[2], b[2], c[2]; bool on[2];
#pragma unroll
                    for (int q = 0; q < 2; ++q) { const int i = i0 + q * NGT; on[q] = i < cfg::MT * 64; const int ii = on[q] ? i : i0; const int row = ii >> 6, c8 = (ii & 63) * 8, h = c8 >> 7;
                        l0[q] = LSE[((size_t)0 * cfg::MT + row) * 4 + h]; l1[q] = LSE[((size_t)1 * cfg::MT + row) * 4 + h]; l2[q] = LSE[((size_t)2 * cfg::MT + row) * 4 + h];
                        a[q] = *(const GAS u32x4g*)(OG + ((size_t)0 * cfg::MT + row) * 512 + c8); b[q] = *(const GAS u32x4g*)(OG + ((size_t)1 * cfg::MT + row) * 512 + c8); c[q] = *(const GAS u32x4g*)(OG + ((size_t)2 * cfg::MT + row) * 512 + c8); }
#pragma unroll
                    for (int q = 0; q < 2; ++q) { if (!on[q]) continue; const int i = i0 + q * NGT, row = i >> 6, c8 = (i & 63) * 8;
                        const float mx = fmaxf(l0[q], fmaxf(l1[q], l2[q])); float w0 = __expf(l0[q] - mx), w1 = __expf(l1[q] - mx), w2 = __expf(l2[q] - mx); const float inv = 1.0f / (w0 + w1 + w2); w0 *= inv; w1 *= inv; w2 *= inv;
                        u32x4g o;
                        o.x = cvtpk(w0 * bf_lo(a[q].x) + w1 * bf_lo(b[q].x) + w2 * bf_lo(c[q].x), w0 * bf_hi(a[q].x) + w1 * bf_hi(b[q].x) + w2 * bf_hi(c[q].x));
                        o.y = cvtpk(w0 * bf_lo(a[q].y) + w1 * bf_lo(b[q].y) + w2 * bf_lo(c[q].y), w0 * bf_hi(a[q].y) + w1 * bf_hi(b[q].y) + w2 * bf_hi(c[q].y));
                        o.z = cvtpk(w0 * bf_lo(a[q].z) + w1 * bf_lo(b[q].z) + w2 * bf_lo(c[q].z), w0 * bf_hi(a[q].z) + w1 * bf_hi(b[q].z) + w2 * bf_hi(c[q].z));
                        o.w = cvtpk(w0 * bf_lo(a[q].w) + w1 * bf_lo(b[q].w) + w2 * bf_lo(c[q].w), w0 * bf_hi(a[q].w) + w1 * bf_hi(b[q].w) + w2 * bf_hi(c[q].w));
                        *(GAS u32x4g*)(MRG + (size_t)row * 512 + c8) = o; } }
            }
            PH_END;
            PH_BEGIN(5)
                { pg8::Gemm g{MRG, Woa + (size_t)j * 2048 * 512, cfg::MP, 2048, 512}; pg8::StaticOrder S; S.init(cfg::MP, 2048, G, bx);
                  ep::EpiResid E{rep_ ? BIG : YB, rep_ ? (float*)(BIG + (size_t)32 * 1024 * 1024) : SSQ};
                  pg8::gemm_phase<ep::EpiResid, pg8::StaticOrder, true, true>(lds, g, S, E); }
                SEpiResid se{Ys, YBs, SSQS};
                if (rep_ == 0) for (int sr_ = 0; sr_ < (((PROBE_MASK) >> 6) & 1) + 1; ++sr_) { SEpiResid se2{sr_ ? (float*)(BIG + (size_t)40 * 1024 * 1024) : Ys, sr_ ? BIG + (size_t)60 * 1024 * 1024 : YBs, sr_ ? (float*)(BIG + (size_t)70 * 1024 * 1024) : SSQS}; sample_gemm(lds, MRG + (size_t)cfg::MP * 512, Woa + (size_t)j * 2048 * 512, 2048, 512, bx, G, se2, sr_ ? PROBE_SMODE : 0); }
                if (layer == 0 && rep_ == 0) {
                    ep::PrepOrder S{0, bx, G, KVB, WQNT}; pg8::Gemm g{nullptr, nullptr, 256, 2048, 512, 4096, 2048};
                    ep::EpiPrep E{MKT, 2048, 0.04419417382415922f * cfg::LOG2E, (size_t)1024 * 2048, (size_t)256 * 2048};
                    pg8::gemm_phase<ep::EpiPrep, ep::PrepOrder, true, true>(lds, g, S, E);
                    ep::PrepOrder S1{1, (G == 256) ? bx - 128 : bx, (G == 256) ? 128 : G, KVB, Wo}; pg8::Gemm g1{nullptr, nullptr, 2048, 256, 512, 2048, 4096};
                    ep::EpiPrep E1{VWT, 1024, 1.0f, (size_t)2048 * 1024, (size_t)256};
                    pg8::gemm_phase<ep::EpiPrep, ep::PrepOrder, true, true>(lds, g1, S1, E1); }
            }
            PH_END;
        } else {
            PH_BEGIN(1)
                { pg8::Gemm g{YB, Winb + (size_t)j * 6144 * 2048, cfg::MP, cfg::NINB, 2048}; pg8::StaticOrder S; S.init(cfg::MP, cfg::NINB, G, bx);
                  ep::EpiScale E{BIG, cfg::NINB, SSQ, 1.f, (LAS float*)(lds + 131072 + 1024)};
                  pg8::gemm_phase<ep::EpiScale, pg8::StaticOrder, true, true>(lds, g, S, E); }
                sample_rstd_table(rstab, SSQS);
                SEpiF32 se{U3S, cfg::NINB, rstab, out, 0, j};
                sample_gemm64(lds, YBs, Winb + (size_t)j * 6144 * 2048, cfg::NINB, 2048, bx, G, se);
            }
            PH_END;
            PH_BEGIN(3)
                const float* cw = ka->in[17] + (size_t)j * 3 * 2048;
                for (int i = gt; i < 512 * 256; i += NGT) { const int chunk = i >> 8, c8 = (i & 255) * 8, row0 = chunk * 16, t0 = row0 & 2047, nb = row0 >> 11;
                    float w0[8], w1[8], w2[8], p2[8], p1[8];
#pragma unroll
                    for (int e = 0; e < 8; ++e) { w0[e] = cw[c8 + e]; w1[e] = cw[2048 + c8 + e]; w2[e] = cw[4096 + c8 + e]; p2[e] = 0.f; p1[e] = 0.f; }
                    if (t0 != 0) { const bf16* rp = BIG + (size_t)(row0 - 2) * cfg::NINB + c8;
                        float g0[8], v0[8], g1[8], v1[8];
                        unpack8(g0, *(const GAS u32x4g*)(rp + 2048)); unpack8(v0, *(const GAS u32x4g*)(rp + 4096)); unpack8(g1, *(const GAS u32x4g*)(rp + cfg::NINB + 2048)); unpack8(v1, *(const GAS u32x4g*)(rp + cfg::NINB + 4096));
#pragma unroll
                        for (int e = 0; e < 8; ++e) { p2[e] = g0[e] * v0[e]; p1[e] = g1[e] * v1[e]; } }
                    for (int q0 = 0; q0 < 16; q0 += 4) {
                        u32x4g gbv[4], gcv[4], vlv[4];
#pragma unroll
                        for (int jq = 0; jq < 4; ++jq) { const bf16* rp = BIG + (size_t)(row0 + q0 + jq) * cfg::NINB + c8;
                            gbv[jq] = __builtin_nontemporal_load((const GAS u32x4g*)rp); gcv[jq] = __builtin_nontemporal_load((const GAS u32x4g*)(rp + 2048)); vlv[jq] = __builtin_nontemporal_load((const GAS u32x4g*)(rp + 4096)); }
#pragma unroll
                        for (int jq = 0; jq < 4; ++jq) { const int row = row0 + q0 + jq, t = t0 + q0 + jq;
                            float cv[8], gbf[8], o[8], gcf[8], vlf[8];
                            unpack8(gbf, gbv[jq]); unpack8(gcf, gcv[jq]); unpack8(vlf, vlv[jq]);
#pragma unroll
                            for (int e = 0; e < 8; ++e) cv[e] = gcf[e] * vlf[e];
#pragma unroll
                            for (int e = 0; e < 8; ++e) { o[e] = gbf[e] * (w0[e] * p2[e] + w1[e] * p1[e] + w2[e] * cv[e]); p2[e] = p1[e]; p1[e] = cv[e]; }
                            u32x4g w; w.x = cvtpk(o[0], o[1]); w.y = cvtpk(o[2], o[3]); w.z = cvtpk(o[4], o[5]); w.w = cvtpk(o[6], o[7]);
                            *(GAS u32x4g*)(MRG + (size_t)row * 2048 + c8) = w;
                            if (t >= 2046) { float* d = out + cfg::O_PCB + ((size_t)(j * 4 + nb) * 2 + (t - 2046)) * 2048 + c8;
                                *(GAS f32x4*)d = (f32x4){cv[0], cv[1], cv[2], cv[3]}; *(GAS f32x4*)(d + 4) = (f32x4){cv[4], cv[5], cv[6], cv[7]}; } } } }
                for (int i = gt; i < 8 * 512; i += NGT) { const int n = i >> 9, c4 = (i & 511) * 4;
                    const f32x4 w0 = *(const GAS f32x4*)(cw + c4), w1 = *(const GAS f32x4*)(cw + 2048 + c4), w2 = *(const GAS f32x4*)(cw + 4096 + c4);
                    const float* st = ka->in[6] + ((size_t)(j * 8 + n) * 2) * 2048 + c4;
                    f32x4 p2 = *(const GAS f32x4*)st, p1 = *(const GAS f32x4*)(st + 2048);
                    f32x4 gbv[8], gcv[8], vlv[8];
#pragma unroll
                    for (int t = 0; t < 8; ++t) { const float* rp = U3S + (size_t)(n * 8 + t) * cfg::NINB + c4; gbv[t] = *(const GAS f32x4*)rp; gcv[t] = *(const GAS f32x4*)(rp + 2048); vlv[t] = *(const GAS f32x4*)(rp + 4096); }
#pragma unroll
                    for (int t = 0; t < 8; ++t) { const f32x4 gb = gbv[t], gc = gcv[t], vl = vlv[t];
                        const f32x4 cv = gc * vl; const f32x4 o = gb * (w0 * p2 + w1 * p1 + w2 * cv); p2 = p1; p1 = cv;
                        u32x2g w; w.x = cvtpk(o[0], o[1]); w.y = cvtpk(o[2], o[3]); *(GAS u32x2g*)(MRG + (size_t)(cfg::MP + n * 8 + t) * 2048 + c4) = w;
                        if (t >= 6) *(GAS f32x4*)(out + cfg::O_SCB + ((size_t)(j * 8 + n) * 2 + (t - 6)) * 2048 + c4) = cv; } }
            }
            PH_END;
            PH_BEGIN(5)
                { pg8::Gemm g{MRG, Wob + (size_t)j * 2048 * 2048, cfg::MP, 2048, 2048}; pg8::StaticOrder S; S.init(cfg::MP, 2048, G, bx);
                  ep::EpiResid E{rep_ ? BIG : YB, rep_ ? (float*)(BIG + (size_t)32 * 1024 * 1024) : SSQ};
                  pg8::gemm_phase<ep::EpiResid, pg8::StaticOrder, true, true>(lds, g, S, E); }
                SEpiResid se{Ys, YBs, SSQS};
                if (rep_ == 0) for (int sr_ = 0; sr_ < (((PROBE_MASK) >> 6) & 1) + 1; ++sr_) { SEpiResid se2{sr_ ? (float*)(BIG + (size_t)40 * 1024 * 1024) : Ys, sr_ ? BIG + (size_t)60 * 1024 * 1024 : YBs, sr_ ? (float*)(BIG + (size_t)70 * 1024 * 1024) : SSQS}; sample_gemm(lds, MRG + (size_t)cfg::MP * 2048, Wob + (size_t)j * 2048 * 2048, 2048, 2048, bx, G, se2, sr_ ? PROBE_SMODE : 0); }
            }
            PH_END;
        }
        PH_BEGIN(1)
            const float qs = 0.04419417382415922f * cfg::LOG2E;
            { pg8::Gemm g{YB, MKT + (size_t)(layer & 1) * 4 * 1024 * 2048, cfg::MP, 1024, 2048}; ep::ScoreOrder S; S.init(cfg::MP, 1024, G, bx); S.MK = g.Bt;
              ep::EpiSoftmax E{QM, SSQ, (LAS float*)(lds + 131072 + 1024)};
              pg8::gemm_phase<ep::EpiSoftmax, ep::ScoreOrder, false, true>(lds, g, S, E); }
            if (G != 256 || bx >= 128) { const int w = (G == 256) ? bx - 128 : bx, nw = (G == 256) ? 128 : G;
                if (layer < 3) { ep::PrepOrder S{0, w, nw, KVB + (size_t)(layer + 1) * cfg::MM * 4096, WQNT + (size_t)(layer + 1) * 2048 * 2048}; pg8::Gemm g{nullptr, nullptr, 256, 2048, 512, 4096, 2048};
                    ep::EpiPrep E{MKT + (size_t)((layer + 1) & 1) * 4 * 1024 * 2048, 2048, qs, (size_t)1024 * 2048, (size_t)256 * 2048};
                    pg8::gemm_phase<ep::EpiPrep, ep::PrepOrder, true, true>(lds, g, S, E);
                    ep::PrepOrder S1{1, w, nw, KVB + (size_t)(layer + 1) * cfg::MM * 4096, Wo + (size_t)(layer + 1) * 2048 * 2048}; pg8::Gemm g1{nullptr, nullptr, 2048, 256, 512, 2048, 4096};
                    ep::EpiPrep E1{VWT + (size_t)((layer + 1) & 1) * 4 * 2048 * 1024, 1024, 1.0f, (size_t)2048 * 1024, (size_t)256};
                    pg8::gemm_phase<ep::EpiPrep, ep::PrepOrder, true, true>(lds, g1, S1, E1); }
                sample_rstd_table(rstab, SSQS);
                SEpiBf16 se{QM + (size_t)cfg::MP * 2048, 2048, rstab, qs};
                sample_gemm(lds, YBs, Wq + (size_t)layer * 2048 * 2048, 2048, 2048, w, nw, se);
                if (layer == 3) { int t2_ = threadIdx.x; asm volatile("" : "+v"(t2_)); KArgs k2 = (KArgs)__builtin_amdgcn_kernarg_segment_ptr(); asm volatile("" : "+s"(k2));
                    const int w2_ = __builtin_amdgcn_readfirstlane(t2_ >> 6); run_slot(11, w * NWAVES + w2_, nw * NWAVES, k2, k2->ws, k2->out, (LAS float*)(lds + w2_ * 17408), t2_ & 63); } }
        }
        PH_END;
        PH_BEGIN(2)
            const int vcu = bx;
            for (int s = vcu; s < 32; s += G) { const int n = s >> 2, h = s & 3;
                const bf16* kb = CKV + ((size_t)(layer * 8 + n) * 256) * 4096 + h * 512;
                memattn_unit<false>(lds, QM + h * 512, cfg::MP + n * 8, true, kb, kb + 2048, OM + h * 512); }
            if (G == 256 && vcu >= 32) run_slot(7 + layer, (vcu - 32) * NWAVES + wave, 224 * NWAVES, ka, ws, out, (LAS float*)(lds + wave * 17408), lane);
            else if (G != 256) run_slot(7 + layer, gw, NGW, ka, ws, out, (LAS float*)(lds + wave * 17408), lane);
            if (PROBE_MASK) __syncthreads();
        }
        PH_END;
        PH_BEGIN(5)
            { pg8::Gemm g{QM  , VWT + (size_t)(layer & 1) * 4 * 2048 * 1024, cfg::MP, 2048, 1024}; ep::OutOrder S; S.init(cfg::MP, 2048, G, bx); S.VW = g.Bt;
              ep::EpiResid E{rep_ ? BIG : YB, rep_ ? (float*)(BIG + (size_t)32 * 1024 * 1024) : SSQ};
              pg8::gemm_phase<ep::EpiResid, ep::OutOrder, true, true>(lds, g, S, E); }
            SEpiResid se{Ys, YBs, SSQS};
            if (rep_ == 0) for (int sr_ = 0; sr_ < (((PROBE_MASK) >> 6) & 1) + 1; ++sr_) { SEpiResid se2{sr_ ? (float*)(BIG + (size_t)40 * 1024 * 1024) : Ys, sr_ ? BIG + (size_t)60 * 1024 * 1024 : YBs, sr_ ? (float*)(BIG + (size_t)70 * 1024 * 1024) : SSQS}; sample_gemm(lds, OM + (size_t)cfg::MP * 2048, Wo + (size_t)layer * 2048 * 2048, 2048, 2048, bx, G, se2, sr_ ? PROBE_SMODE : 0); }
        }
        PH_END;
        PH_BEGIN(1)
            { pg8::Gemm g{YB, Wup + (size_t)layer * 11264 * 2048, cfg::MP, cfg::UP, 2048}; pg8::StaticOrder S; S.init(cfg::MP, cfg::UP, G, bx);
              ep::EpiUpConv E{ACT, SSQ, out, (float*)(ws + cfg::WS_HALO), ka->in[23] + (size_t)layer * 3 * cfg::UP, layer, (LAS float*)(lds + 133120), (LAS float*)(lds + 131072 + 1024)};
              pg8::gemm_phase<ep::EpiUpConv, pg8::StaticOrder, true, true>(lds, g, S, E); }
            sample_rstd_table(rstab, SSQS);
            sample_up_conv(lds, YBs, Wup + (size_t)layer * 11264 * 2048, bx, G, rstab, ka->in[23] + (size_t)layer * 3 * cfg::UP, ka->in[7] + (size_t)layer * 8 * 2 * cfg::UP, out + cfg::O_SFC + (size_t)layer * 8 * 2 * cfg::UP, ACT + (size_t)cfg::MP * cfg::DFF);
            { const int slot = layer == 0 ? 2 : (layer == 1 ? 3 : (layer == 2 ? 5 : 6));
              if (G == 256 && bx >= 128) run_slot(slot, (bx - 128) * NWAVES + wave, 128 * NWAVES, ka, ws, out, (LAS float*)(lds + wave * 17408), lane);
              else if (G != 256) run_slot(slot, gw, NGW, ka, ws, out, (LAS float*)(lds + wave * 17408), lane); }
            if (PROBE_MASK) __syncthreads();
        }
        PH_END;
        PH_BEGIN(5)
            if (rep_ == 0) {
                int t3_ = threadIdx.x; asm volatile("" : "+v"(t3_));
                const float* hal = (const float*)(ws + cfg::WS_HALO); const float* cw = ka->in[23] + (size_t)layer * 3 * cfg::UP;
                int pm_lo = 0, pm_hi = 32;
                if (G == 256) { const int wgid = (bx % 8) * 32 + bx / 8, nig = pg8::WGM * 8; pm_lo = (wgid / nig) * pg8::WGM + (wgid % nig) % pg8::WGM; pm_hi = pm_lo + 1; }
                for (int pm = pm_lo; pm < pm_hi; ++pm) {
                    if ((pm & 7) == 0) continue;
                    for (int i = t3_; i < 1408; i += NTHREADS) { const int c4 = i * 4, colA = 256 * (c4 >> 7) + (c4 & 127);
                        const float* hp = hal + (size_t)((pm - 1) * 4 + 2) * cfg::UP + colA; const float* hc = hal + (size_t)(pm * 4) * cfg::UP + colA;
                        const f32x4 am2 = *(const GAS f32x4*)hp, am1 = *(const GAS f32x4*)(hp + cfg::UP), a0 = *(const GAS f32x4*)hc, a1 = *(const GAS f32x4*)(hc + cfg::UP);
                        const f32x4 bm2 = *(const GAS f32x4*)(hp + 128), bm1 = *(const GAS f32x4*)(hp + cfg::UP + 128), b0 = *(const GAS f32x4*)(hc + 128), b1 = *(const GAS f32x4*)(hc + cfg::UP + 128);
                        const f32x4 wa0 = *(const GAS f32x4*)(cw + c4), wa1 = *(const GAS f32x4*)(cw + cfg::UP + c4), wa2 = *(const GAS f32x4*)(cw + 2 * cfg::UP + c4);
                        const f32x4 wb0 = *(const GAS f32x4*)(cw + cfg::DFF + c4), wb1 = *(const GAS f32x4*)(cw + cfg::UP + cfg::DFF + c4), wb2 = *(const GAS f32x4*)(cw + 2 * cfg::UP + cfg::DFF + c4);
#pragma unroll
                        for (int rr = 0; rr < 2; ++rr) {
                            const f32x4 va = rr == 0 ? wa0 * am2 + wa1 * am1 + wa2 * a0 : wa0 * am1 + wa1 * a0 + wa2 * a1;
                            const f32x4 vb = rr == 0 ? wb0 * bm2 + wb1 * bm1 + wb2 * b0 : wb0 * bm1 + wb1 * b0 + wb2 * b1;
                            f32x4 o; o[0] = va[0] / (1.0f + __expf(-va[0])) * vb[0]; o[1] = va[1] / (1.0f + __expf(-va[1])) * vb[1]; o[2] = va[2] / (1.0f + __expf(-va[2])) * vb[2]; o[3] = va[3] / (1.0f + __expf(-va[3])) * vb[3];
                            u32x2g w; w.x = cvtpk(o[0], o[1]); w.y = cvtpk(o[2], o[3]); *(GAS u32x2g*)(ACT + (size_t)(pm * 256 + rr) * cfg::DFF + c4) = w; } } }
                asm volatile("s_waitcnt vmcnt(0)" ::: "memory"); __syncthreads();
            }
            { pg8::Gemm g{ACT, Wdn + (size_t)layer * 2048 * 5632, cfg::MP, 2048, cfg::DFF}; pg8::StaticOrder S; S.init(cfg::MP, 2048, G, bx);
              ep::EpiResid E{rep_ ? BIG : YB, rep_ ? (float*)(BIG + (size_t)32 * 1024 * 1024) : SSQ};
              pg8::gemm_phase<ep::EpiResid, pg8::StaticOrder, true, true>(lds, g, S, E); }
            SEpiResid se{Ys, YBs, SSQS};
            if (rep_ == 0) for (int sr_ = 0; sr_ < (((PROBE_MASK) >> 6) & 1) + 1; ++sr_) { SEpiResid se2{sr_ ? (float*)(BIG + (size_t)40 * 1024 * 1024) : Ys, sr_ ? BIG + (size_t)60 * 1024 * 1024 : YBs, sr_ ? (float*)(BIG + (size_t)70 * 1024 * 1024) : SSQS}; sample_gemm(lds, ACT + (size_t)cfg::MP * cfg::DFF, Wdn + (size_t)layer * 2048 * 5632, 2048, cfg::DFF, bx, G, se2, sr_ ? PROBE_SMODE : 0); }
        }
        PH_END;
    }
    PH_BEGIN(3)
        const float* gf = ka->in[13];
        for (int m = gw; m < cfg::MT; m += NGW) { f32x4 v[8]; float s = 0.f;
            if (m < cfg::MP) { const GAS u32x2g* yr = (const GAS u32x2g*)(YB + (size_t)m * 2048) + lane;
#pragma unroll
                for (int q = 0; q < 8; ++q) { const u32x2g w = yr[64 * q]; v[q] = (f32x4){bf_lo(w.x), bf_hi(w.x), bf_lo(w.y), bf_hi(w.y)}; } }
            else { const GAS f32x4* yr = (const GAS f32x4*)(Y + (size_t)m * 2048) + lane;
#pragma unroll
                for (int q = 0; q < 8; ++q) v[q] = yr[64 * q]; }
#pragma unroll
            for (int q = 0; q < 8; ++q) s += (v[q].x * v[q].x + v[q].y * v[q].y) + (v[q].z * v[q].z + v[q].w * v[q].w);
            const float rs = 1.0f / sqrtf(wave_sum(s) * (1.0f / 2048.0f) + cfg::EPS);
            GAS f32x4* o = (GAS f32x4*)(out + (m < cfg::MP ? cfg::O_YP + (size_t)m * 2048 : cfg::O_YS + (size_t)(m - cfg::MP) * 2048)) + lane;
#pragma unroll
            for (int q = 0; q < 8; ++q) { const f32x4 gg = ((const GAS f32x4*)gf)[lane + 64 * q]; __builtin_nontemporal_store(v[q] * rs * gg, o + 64 * q); } }
    }
#undef PH_ON
#undef PH_END
#undef PH_VARS
#undef PH_BEGIN
#undef Wqkv
#undef Woa
#undef Winb
#undef Wob
#undef Wq
#undef Wkv
#undef Wo
#undef Wup
#undef Wdn
#undef Y
#undef YB
#undef SSQ
#undef SSQS
#undef MEMB
#undef SSQM
#undef KVB
#undef CKV
#undef BIG
#undef ACT
#undef QM
#undef OM
#undef OG
#undef LSE
#undef MRG
#undef QKVS
#undef U3S
#undef US
#undef Ys
#undef WQNT
#undef MKT
#undef VWT
#undef YBs
}

#ifndef MK_CUTS
#define MK_CUTS 0
#endif
extern "C" void kernel_launch(void* const* d_in, const int* in_sizes, int n_in, void* d_out, int out_size, void* d_ws, size_t ws_size, hipStream_t stream) {
    static int grid = 0;
    if (grid == 0) {
        if (n_in != 25 || (size_t)out_size != cfg::O_END || ws_size < cfg::WS_END) { fprintf(stderr, "kernel_launch: unexpected problem: n_in %d out %d ws %zu (need %zu)\n", n_in, out_size, ws_size, (size_t)cfg::WS_END); grid = -1; return; }
        int dev = 0, cus = 0, per_cu = 0;
        if (hipGetDevice(&dev) != hipSuccess || hipDeviceGetAttribute(&cus, hipDeviceAttributeMultiprocessorCount, dev) != hipSuccess) { grid = -1; return; }
        if (hipFuncSetAttribute((const void*)mk_fwd, hipFuncAttributeMaxDynamicSharedMemorySize, LDS_BYTES) != hipSuccess) { fprintf(stderr, "kernel_launch: hipFuncSetAttribute failed\n"); grid = -1; return; }
        if (hipOccupancyMaxActiveBlocksPerMultiprocessor(&per_cu, (const void*)mk_fwd, NTHREADS, LDS_BYTES) != hipSuccess || per_cu < 1) { fprintf(stderr, "kernel_launch: occupancy query says %d\n", per_cu); }
        (void)hipGetLastError();
        grid = cus;
    }
    if (grid < 0) return;
    (void)hipMemsetAsync((char*)d_ws + cfg::WS_CTL, 0, cfg::CTL_ZERO_BYTES, stream);
    Args a{};
    for (int i = 0; i < 25; ++i) a.in[i] = (const float*)d_in[i];
    a.out = (float*)d_out; a.ws = (unsigned char*)d_ws;
#if MK_CUTS == 0
    a.ph_lo = 0; a.ph_hi = 1000;
    hipLaunchKernelGGL(mk_fwd, dim3(grid), dim3(NTHREADS), LDS_BYTES, stream, a);
#else
    for (int p = 0; p < 2 + 2 * 10 + 2 * 9 + 1; ++p) { a.ph_lo = p; a.ph_hi = p + 1; hipLaunchKernelGGL(mk_fwd, dim3(grid), dim3(NTHREADS), LDS_BYTES, stream, a); }
#endif
}
```
